# Optimizing an MI355X kernel written in HIP

```python
import jax, jax.numpy as jnp
from jax import lax
import numpy as np

D_MODEL = 2048
BATCH = 8
SEQ = 2048
DEPTH = 2

N_EVEN = (DEPTH + 1) // 2
N_ODD = DEPTH // 2
BRANCH = D_MODEL
MIX_WIDTH = 2 * BRANCH

A_HEAD_DIM = 128
A_HEADS = BRANCH // A_HEAD_DIM
A_CHUNK = 32
B_GROUPS = 8
B_GROUP_DIM = BRANCH // B_GROUPS
C_CONV = 3
D_HEAD_DIM = 64
D_HEADS = BRANCH // D_HEAD_DIM
D_GROUPS = 4
D_HPG = D_HEADS // D_GROUPS
D_STATE = 128
D_CONV = 3
D_CHUNK = 64
D_XBC = BRANCH + 2 * D_GROUPS * D_STATE
EPS = 1e-6

EV_SIZES = (BRANCH, BRANCH, BRANCH, BRANCH, BRANCH, BRANCH, BRANCH)
OD_SIZES = (BRANCH, BRANCH, BRANCH, BRANCH, BRANCH, D_XBC, 2 * D_HEADS)
EV_COLS = sum(EV_SIZES)
OD_COLS = sum(OD_SIZES)

kernel_name = "hybrid_hgrn2_fnet_shortconv_ssd_encoder"


def rms_norm(x, w):
    xf = x.astype(jnp.float32)
    y = xf * lax.rsqrt(jnp.mean(xf * xf, axis=-1, keepdims=True) + EPS) * w.astype(jnp.float32)
    return y.astype(x.dtype)


def split_cols(t, sizes):
    idx = np.cumsum(np.array(sizes))[:-1].tolist()
    return jnp.split(t, idx, axis=-1)


def flip(t):
    return t[:, ::-1]


def centred_dwconv(u, w):
    k_w = w.shape[0]
    pad = k_w // 2
    length = u.shape[1]
    up = jnp.pad(u, ((0, 0), (pad, pad), (0, 0)))
    y = up[:, 0:length] * w[0]
    for k in range(1, k_w):
        y = y + up[:, k:k + length] * w[k]
    return y


def gla_chunked(q, k, v, logf):
    bn, length, h, dk = q.shape
    dv = v.shape[-1]
    nc = length // A_CHUNK
    chunks = lambda t: jnp.moveaxis(t.reshape(bn, nc, A_CHUNK, h, t.shape[-1]), 1, 0)
    mask = jnp.tril(jnp.ones((A_CHUNK, A_CHUNK), dtype=bool))

    def step(state, inp):
        qc, kc, vc, gc = inp
        b = jnp.cumsum(gc, axis=1)
        b_last = b[:, -1:]
        q_in = qc * jnp.exp(b)
        k_in = kc * jnp.exp(-b)
        scores = jnp.where(mask, jnp.einsum('bihk,bjhk->bhij', q_in, k_in), 0.0)
        o = (jnp.einsum('bhij,bjhv->bihv', scores, vc)
             + jnp.einsum('bihk,bhkv->bihv', q_in, state))
        k_end = kc * jnp.exp(b_last - b)
        state = (jnp.exp(b_last[:, 0])[..., None] * state
                 + jnp.einsum('bjhk,bjhv->bhkv', k_end, vc))
        return state, o

    s0 = jnp.zeros((bn, h, dk, dv), q.dtype)
    _, o = lax.scan(step, s0, (chunks(q), chunks(k), chunks(v), chunks(logf)))
    return jnp.moveaxis(o, 0, 1).reshape(bn, length, h, dv)


def hgrn2_mixer(a_q, a_i, a_ff, a_fb, lb, norm_w):
    bn, length, _ = a_q.shape
    heads = lambda t: t.astype(jnp.float32).reshape(bn, length, A_HEADS, A_HEAD_DIM)
    q, v = heads(a_q), heads(a_i)
    lb = lb.astype(jnp.float32).reshape(A_HEADS, A_HEAD_DIM)

    def gates(zf):
        z = heads(zf)
        logf = jnp.log(lb + (1.0 - lb) * jax.nn.sigmoid(z))
        key = (1.0 - lb) * jax.nn.sigmoid(-z)
        return key, logf

    k_f, g_f = gates(a_ff)
    k_b, g_b = gates(a_fb)
    o = (gla_chunked(q, k_f, v, g_f)
         + flip(gla_chunked(flip(q), flip(k_b), flip(v), flip(g_b))))
    o = o * lax.rsqrt(jnp.mean(o * o, axis=-1, keepdims=True) + EPS)
    return (o.reshape(bn, length, BRANCH) * norm_w.astype(jnp.float32)).astype(a_q.dtype)


def fourier_mixer(u, fw, fb):
    bn, length, _ = u.shape
    ug = u.astype(jnp.float32).reshape(bn, length, B_GROUPS, B_GROUP_DIM)
    mixed = jnp.fft.fft2(ug, axes=(1, 3), norm="ortho").real
    y = jnp.einsum('blgc,gcd->blgd', mixed, fw.astype(jnp.float32)).reshape(bn, length, BRANCH)
    return (y + fb.astype(jnp.float32)).astype(u.dtype)


def ssd_chunked(x, dt, a, bm, cm):
    bn, length, g, hg, p = x.shape
    n = bm.shape[-1]
    nc = length // D_CHUNK
    chunks = lambda t: jnp.moveaxis(t.reshape(bn, nc, D_CHUNK, *t.shape[2:]), 1, 0)
    mask = jnp.tril(jnp.ones((D_CHUNK, D_CHUNK), dtype=bool))[None, :, :, None, None]

    def step(state, inp):
        xc, dtc, bc, cc = inp
        acum = jnp.cumsum(dtc * a, axis=1)
        decay = jnp.exp(jnp.where(mask, acum[:, :, None] - acum[:, None, :], -jnp.inf))
        xdt = xc * dtc[..., None]
        cb = jnp.einsum('bign,bjgn->bijg', cc, bc)
        y = jnp.einsum('bijg,bijgh,bjghp->bighp', cb, decay, xdt)
        y = y + jnp.einsum('bign,bghpn->bighp', cc, state) * jnp.exp(acum)[..., None]
        to_end = jnp.exp(acum[:, -1:] - acum)
        state = (state * jnp.exp(acum[:, -1])[..., None, None]
                 + jnp.einsum('bjgn,bjgh,bjghp->bghpn', bc, to_end, xdt))
        return state, y

    s0 = jnp.zeros((bn, g, hg, p, n), x.dtype)
    _, y = lax.scan(step, s0, (chunks(x), chunks(dt), chunks(bm), chunks(cm)))
    return jnp.moveaxis(y, 0, 1).reshape(bn, length, g, hg, p)


def ssd_mixer(d_xbc, d_dt, d_z, conv_w, conv_b, dt_bias, a_log, d_skip, norm_w):
    bn, length, _ = d_xbc.shape
    xbc = jax.nn.silu(centred_dwconv(d_xbc, conv_w) + conv_b).astype(jnp.float32)
    xs, bm, cm = split_cols(xbc, (BRANCH, D_GROUPS * D_STATE, D_GROUPS * D_STATE))
    xs = xs.reshape(bn, length, D_GROUPS, D_HPG, D_HEAD_DIM)
    bm = bm.reshape(bn, length, D_GROUPS, D_STATE)
    cm = cm.reshape(bn, length, D_GROUPS, D_STATE)
    dt = jax.nn.softplus(d_dt.astype(jnp.float32).reshape(bn, length, 2, D_HEADS)
                         + dt_bias.astype(jnp.float32))
    dt = dt.reshape(bn, length, 2, D_GROUPS, D_HPG)
    a = (-jnp.exp(a_log.astype(jnp.float32))).reshape(2, D_GROUPS, D_HPG)
    y = (ssd_chunked(xs, dt[:, :, 0], a[0], bm, cm)
         + flip(ssd_chunked(flip(xs), flip(dt[:, :, 1]), a[1], flip(bm), flip(cm))))
    y = y + xs * d_skip.astype(jnp.float32).reshape(D_GROUPS, D_HPG)[..., None]
    y = y.reshape(bn, length, BRANCH) * jax.nn.silu(d_z.astype(jnp.float32))
    return rms_norm(y, norm_w).astype(d_z.dtype)


def even_layer(h, w_in, w_out, lb, hgrn_nw, fw, fb):
    a_q, a_i, a_ff, a_fb, a_g, b_u, b_g = split_cols(h @ w_in, EV_SIZES)
    a_out = hgrn2_mixer(a_q, a_i, a_ff, a_fb, lb, hgrn_nw) * jax.nn.silu(a_g)
    b_out = fourier_mixer(b_u, fw, fb) * jax.nn.silu(b_g)
    return jnp.concatenate([a_out, b_out], axis=-1) @ w_out


def odd_layer(h, w_in, w_out, sconv_w, conv_w, conv_b, dt_bias, a_log, d_skip, ssd_nw):
    c_in, c_b, c_c, c_g, d_z, d_xbc, d_dt = split_cols(h @ w_in, OD_SIZES)
    c_out = c_b * centred_dwconv(c_c * c_in, sconv_w) * jax.nn.silu(c_g)
    d_out = ssd_mixer(d_xbc, d_dt, d_z, conv_w, conv_b, dt_bias, a_log, d_skip, ssd_nw)
    return jnp.concatenate([c_out, d_out], axis=-1) @ w_out


def setup_inputs(seed: int = 0) -> dict:
    key = jax.random.key(seed)
    ks = jax.random.split(key, 18)
    f32 = jnp.float32
    nrm = lambda k, shape, s: jax.random.normal(k, shape, f32) * s
    dt_init = jnp.exp(jax.random.uniform(ks[14], (N_ODD, 2, D_HEADS), f32)
                      * (np.log(0.1) - np.log(0.001)) + np.log(0.001))
    return {
        "x": nrm(ks[0], (BATCH, SEQ, D_MODEL), 1.0),
        "norm_w": 1.0 + nrm(ks[1], (DEPTH, D_MODEL), 0.02),
        "final_norm_w": 1.0 + nrm(ks[2], (D_MODEL,), 0.02),
        "ev_w_in": nrm(ks[3], (N_EVEN, D_MODEL, EV_COLS), D_MODEL ** -0.5),
        "ev_w_out": nrm(ks[4], (N_EVEN, MIX_WIDTH, D_MODEL), MIX_WIDTH ** -0.5),
        "hgrn_lb_logits": nrm(ks[5], (DEPTH + 1, BRANCH), 0.1),
        "hgrn_norm_w": 1.0 + nrm(ks[6], (N_EVEN, BRANCH), 0.02),
        "fnet_w": nrm(ks[7], (N_EVEN, B_GROUPS, B_GROUP_DIM, B_GROUP_DIM), B_GROUP_DIM ** -0.5),
        "fnet_b": nrm(ks[8], (N_EVEN, BRANCH), 0.01),
        "od_w_in": nrm(ks[9], (N_ODD, D_MODEL, OD_COLS), D_MODEL ** -0.5),
        "od_w_out": nrm(ks[10], (N_ODD, MIX_WIDTH, D_MODEL), MIX_WIDTH ** -0.5),
        "sconv_w": nrm(ks[11], (N_ODD, C_CONV, BRANCH), C_CONV ** -0.5),
        "ssd_conv_w": nrm(ks[12], (N_ODD, D_CONV, D_XBC), D_CONV ** -0.5),
        "ssd_conv_b": nrm(ks[13], (N_ODD, D_XBC), 0.01),
        "ssd_dt_bias": dt_init + jnp.log(-jnp.expm1(-dt_init)),
        "ssd_a_log": jnp.log(jax.random.uniform(ks[15], (N_ODD, 2, D_HEADS), f32, 1.0, 16.0)),
        "ssd_d": 1.0 + nrm(ks[16], (N_ODD, D_HEADS), 0.1),
        "ssd_norm_w": 1.0 + nrm(ks[17], (N_ODD, BRANCH), 0.02),
    }


def reference(x, norm_w, final_norm_w, ev_w_in, ev_w_out, hgrn_lb_logits, hgrn_norm_w,
              fnet_w, fnet_b, od_w_in, od_w_out, sconv_w, ssd_conv_w, ssd_conv_b,
              ssd_dt_bias, ssd_a_log, ssd_d, ssd_norm_w):
    lower_bounds = jnp.cumsum(jax.nn.softmax(hgrn_lb_logits.astype(jnp.float32), axis=0), axis=0)
    for layer in range(DEPTH):
        h = rms_norm(x, norm_w[layer])
        if layer % 2 == 0:
            e = layer // 2
            x = x + even_layer(h, ev_w_in[e], ev_w_out[e], lower_bounds[layer],
                               hgrn_norm_w[e], fnet_w[e], fnet_b[e])
        else:
            o = layer // 2
            x = x + odd_layer(h, od_w_in[o], od_w_out[o], sconv_w[o], ssd_conv_w[o],
                              ssd_conv_b[o], ssd_dt_bias[o], ssd_a_log[o], ssd_d[o],
                              ssd_norm_w[o])
    return rms_norm(x, final_norm_w)
```

```cpp
#include <hip/hip_runtime.h>
#include <hip/hip_cooperative_groups.h>
#include <cstdio>
namespace cg = cooperative_groups;

#define LAS __attribute__((address_space(3)))
typedef unsigned short bf16_t;
typedef short bf16x8 __attribute__((ext_vector_type(8)));
typedef float f32x4 __attribute__((ext_vector_type(4)));
typedef float f32x2 __attribute__((ext_vector_type(2)));
typedef unsigned u32x4 __attribute__((ext_vector_type(4)));
typedef unsigned u32x2 __attribute__((ext_vector_type(2)));

constexpr int TOK = 16384, DM = 2048, SEQ = 2048;
constexpr size_t MiB = 1ull << 20;
constexpr size_t WS_WIN = 0, WS_WOUT = 56 * MiB, WS_S0 = 72 * MiB, WS_S1 = 136 * MiB, WS_S2 = 200 * MiB, WS_S3 = 264 * MiB,
                 WS_DFT = 328 * MiB, WS_W12 = 344 * MiB, WS_P1024 = 346 * MiB, WS_H = 348 * MiB, WS_UF = 412 * MiB;
constexpr size_t WS_X1 = WS_S0, WS_H1 = 200 * MiB, WS_CIN = 264 * MiB, WS_CB = 328 * MiB, WS_CC = 392 * MiB,
                 WS_XBC = 264 * MiB, WS_DT = 360 * MiB, WS_YF = 368 * MiB, WS_YB = 432 * MiB,
                 WS_XACT = 200 * MiB  , WS_BCACT = 0  ;
constexpr int LDS_BYTES = 131072 + 16;
constexpr float EPS = 1e-6f;

struct Params {
    const float* x; const float* norm_w; const float* final_norm_w; const float* ev_w_in; const float* ev_w_out;
    const float* lb_logits; const float* hgrn_norm_w; const float* fnet_w; const float* fnet_b;
    const float* od_w_in; const float* od_w_out; const float* sconv_w; const float* ssd_conv_w; const float* ssd_conv_b;
    const float* dt_bias; const float* a_log; const float* ssd_d; const float* ssd_norm_w;
    float* out; unsigned char* ws;
    int ph_lo, ph_hi;
};

typedef __bf16 bf16x2_t __attribute__((ext_vector_type(2)));
__device__ __forceinline__ unsigned cvt_pk_bf16(float lo, float hi) {
    f32x2 v = {lo, hi}; union { bf16x2_t b; unsigned u; } c; c.b = __builtin_convertvector(v, bf16x2_t); return c.u; }
__device__ __forceinline__ float bf_lo(unsigned w) { return __uint_as_float(w << 16); }
__device__ __forceinline__ float bf_hi(unsigned w) { return __uint_as_float(w & 0xffff0000u); }
__device__ __forceinline__ void unpack8(const u32x4 v, float* f) {
    f[0] = bf_lo(v[0]); f[1] = bf_hi(v[0]); f[2] = bf_lo(v[1]); f[3] = bf_hi(v[1]);
    f[4] = bf_lo(v[2]); f[5] = bf_hi(v[2]); f[6] = bf_lo(v[3]); f[7] = bf_hi(v[3]);
}
__device__ __forceinline__ u32x4 pack8(const float* f) {
    u32x4 r; r[0] = cvt_pk_bf16(f[0], f[1]); r[1] = cvt_pk_bf16(f[2], f[3]); r[2] = cvt_pk_bf16(f[4], f[5]); r[3] = cvt_pk_bf16(f[6], f[7]); return r;
}
__device__ __forceinline__ float silu_f(float x) { return x / (1.0f + __expf(-x)); }
__device__ __forceinline__ bf16x8 as_bf16x8(u32x4 v) { union { u32x4 u; bf16x8 b; } c; c.u = v; return c.b; }
__device__ __forceinline__ bf16x8 lds_b128(LAS unsigned char* p) { return *(LAS bf16x8*)p; }
__device__ __forceinline__ bf16x8 lds_2xb64(LAS unsigned char* p0, LAS unsigned char* p1) {
    u32x2 a = *(LAS u32x2*)p0, b = *(LAS u32x2*)p1; u32x4 v; v[0] = a[0]; v[1] = a[1]; v[2] = b[0]; v[3] = b[1]; return as_bf16x8(v);
}
__device__ __forceinline__ bf16x8 pack_acc2(const f32x4 a, const f32x4 b) {
    u32x4 v; v[0] = cvt_pk_bf16(a[0], a[1]); v[1] = cvt_pk_bf16(a[2], a[3]); v[2] = cvt_pk_bf16(b[0], b[1]); v[3] = cvt_pk_bf16(b[2], b[3]); return as_bf16x8(v);
}
__device__ __forceinline__ int opaque_tid(const int wbase) { int t = wbase + (int)__builtin_amdgcn_mbcnt_hi(~0u, __builtin_amdgcn_mbcnt_lo(~0u, 0u)); asm volatile("" : "+v"(t)); return t; }
typedef short s16x4 __attribute__((ext_vector_type(4)));
constexpr int PN = 288;
__device__ __forceinline__ int rowaddr(int r) { return r * PN + ((r >> 3) & 7) * 16; }
__device__ __forceinline__ bf16x8 lds_tr_frag(LAS unsigned char* base, int r0, int c0, int lane) {
    const int g = lane >> 4, q = (lane & 15) >> 2, pp = lane & 3;
    LAS unsigned char* a0 = base + rowaddr(r0 + 8 * g + q) + c0 * 2 + 8 * pp;
    const s16x4 lo = __builtin_amdgcn_ds_read_tr16_b64_v4i16((LAS s16x4*)a0);
    const s16x4 hi = __builtin_amdgcn_ds_read_tr16_b64_v4i16((LAS s16x4*)(a0 + 4 * PN));
    bf16x8 r; r[0] = lo[0]; r[1] = lo[1]; r[2] = lo[2]; r[3] = lo[3]; r[4] = hi[0]; r[5] = hi[1]; r[6] = hi[2]; r[7] = hi[3]; return r;
}
#define MFMA16(a, b, c) __builtin_amdgcn_mfma_f32_16x16x32_bf16((a), (b), (c), 0, 0, 0)

constexpr int BM = 256, BK = 64, HALF = 128, HTB = HALF * BK * 2, NXCD = 8, WGM = 4;
__device__ __forceinline__ int lds_byte(int r, int c) { const int st = (r >> 4) * 2 + (c >> 5), rr = r & 15, cc = c & 31, ob = rr * 64 + cc * 2; return st * 1024 + (ob ^ (((ob >> 9) & 1) << 5)); }
__device__ __forceinline__ void stage_rc(int b, int& R, int& C) { const int st = b / 1024, sb = b % 1024, swz = sb ^ (((sb >> 9) & 1) << 5); R = (st >> 1) * 16 + swz / 64; C = (st & 1) * 32 + (swz % 64) / 2; }
__device__ __forceinline__ int perm32(int rho) { const int n = rho >> 4, i = rho & 15; return 8 * (i >> 2) + 4 * n + (i & 3); }

__device__ __forceinline__ bf16_t* rfl_ptr(bf16_t* p) { const unsigned long long v = (unsigned long long)p; const unsigned lo = __builtin_amdgcn_readfirstlane((unsigned)v), hi = __builtin_amdgcn_readfirstlane((unsigned)(v >> 32)); return (bf16_t*)(((unsigned long long)hi << 32) | lo); }
enum { MODE_SEG = 0, MODE_PT = 1, MODE_DFT = 2, MODE_RES0 = 3, MODE_RES1 = 4, MODE_PAIR = 5 };
struct GemmJob {
    const char* A; const char* Bt; size_t strideAz, strideBz, strideBpm;
    int lda, ldb, nM, nN, Z, K, mode;
    bf16_t* c0; bf16_t* c1; bf16_t* c2; bf16_t* c3; bf16_t* c4;
    int ld0, ld1, ld2, ld3, ld4, t1, t2, t3, t4;
    const float* fbias; const float* resid; float* outf;
};
struct Unit { int z, pm, pn; };

__device__ __forceinline__ bool next_unit(const GemmJob& g, int i, Unit& u) {
    const int nwg = g.nM * g.nN;
    const long L = (long)i * gridDim.x + blockIdx.x;
    if (L >= (long)g.Z * nwg) return false;
    const int z = (int)(L / nwg); int wgid = (int)(L - (long)z * nwg);
    { const int q = nwg / NXCD, r = nwg % NXCD, xcd = wgid % NXCD, off = wgid / NXCD; wgid = (xcd < r ? xcd * (q + 1) : r * (q + 1) + (xcd - r) * q) + off; }
    const int nig = WGM * g.nN, gid = wgid / nig, fm = gid * WGM, gsz = (g.nM - fm) < WGM ? (g.nM - fm) : WGM;
    u.pm = fm + ((wgid % nig) % gsz); u.pn = (wgid % nig) / gsz; u.z = z; return true;
}

__device__ __forceinline__ void gemm_epilogue(const f32x4 (&acc)[2][2][4][2], const GemmJob& g, const Unit& u, int wr, int wc, int fr, int fq) {
    const int rloc = wr * 64 + fr, cloc = wc * 32 + 8 * fq;
    if (g.mode == MODE_SEG || g.mode == MODE_PT) {
        bf16_t* base; int ld;
        if (g.mode == MODE_SEG) {
            bf16_t* s0 = g.c0; bf16_t* s1 = g.c1; bf16_t* s2 = g.c2; bf16_t* s3 = g.c3; bf16_t* s4 = g.c4;
            int e0 = g.ld0, e1 = g.ld1, e2 = g.ld2, e3 = g.ld3, e4 = g.ld4, f1 = g.t1, f2 = g.t2, f3 = g.t3, f4 = g.t4;
            s0 = rfl_ptr(s0); s1 = rfl_ptr(s1); s2 = rfl_ptr(s2); s3 = rfl_ptr(s3); s4 = rfl_ptr(s4);
            e0 = __builtin_amdgcn_readfirstlane(e0); e1 = __builtin_amdgcn_readfirstlane(e1); e2 = __builtin_amdgcn_readfirstlane(e2); e3 = __builtin_amdgcn_readfirstlane(e3); e4 = __builtin_amdgcn_readfirstlane(e4);
            f1 = __builtin_amdgcn_readfirstlane(f1); f2 = __builtin_amdgcn_readfirstlane(f2); f3 = __builtin_amdgcn_readfirstlane(f3); f4 = __builtin_amdgcn_readfirstlane(f4);
            base = s0; ld = e0; int t0 = 0;
            if (u.pn >= f1) { base = s1; ld = e1; t0 = f1; }
            if (u.pn >= f2) { base = s2; ld = e2; t0 = f2; }
            if (u.pn >= f3) { base = s3; ld = e3; t0 = f3; }
            if (u.pn >= f4) { base = s4; ld = e4; t0 = f4; }
            base += (size_t)(u.pm * BM) * ld + (size_t)(u.pn - t0) * BM;
        } else {
            const int b = u.pn >> 2, l0 = (u.pn & 3) * 256; ld = 2048;
            base = g.c0 + ((size_t)(b * 2048 + u.z * 256)) * 2048 + (size_t)u.pm * 1024 + l0;
        }
#pragma unroll
        for (int ai = 0; ai < 2; ++ai)
#pragma unroll
            for (int m = 0; m < 4; ++m) {
                bf16_t* rowp = base + (size_t)(rloc + ai * HALF + m * 16) * ld + cloc;
#pragma unroll
                for (int bj = 0; bj < 2; ++bj) {
                    const f32x4 v0 = acc[ai][bj][m][0], v1 = acc[ai][bj][m][1];
                    u32x4 o; o[0] = cvt_pk_bf16(v0[0], v0[1]); o[1] = cvt_pk_bf16(v0[2], v0[3]); o[2] = cvt_pk_bf16(v1[0], v1[1]); o[3] = cvt_pk_bf16(v1[2], v1[3]);
                    *(u32x4*)(rowp + bj * HALF) = o;
                }
            }
    } else if (g.mode == MODE_PAIR) {
        const bool second = u.pn >= 16;
        bf16_t* base = second ? g.c1 : g.c0; const int ld = second ? 4096 : 2048;
        base += (size_t)(u.pm * BM) * ld + (size_t)(u.pn & 15) * 128 + cloc;
#pragma unroll
        for (int ai = 0; ai < 2; ++ai)
#pragma unroll
            for (int m = 0; m < 4; ++m) {
                float r[8];
#pragma unroll
                for (int e = 0; e < 4; ++e) {
                    const float a0 = acc[ai][0][m][0][e], a1 = acc[ai][0][m][1][e], p0 = acc[ai][1][m][0][e], p1 = acc[ai][1][m][1][e];
                    r[e] = second ? a0 * silu_f(p0) : a0 * p0; r[4 + e] = second ? a1 * silu_f(p1) : a1 * p1;
                }
                *(u32x4*)(base + (size_t)(rloc + ai * HALF + m * 16) * ld) = pack8(r);
            }
    } else if (g.mode == MODE_DFT) {
        const int col0 = u.pn * BM + cloc;
        const float sgn = (fr & 1) ? -1.0f : 1.0f;
#pragma unroll
        for (int bj = 0; bj < 2; ++bj) {
            const f32x4 q0 = *(const f32x4*)(g.resid + u.z * 2048 + col0 + bj * HALF), q1 = *(const f32x4*)(g.resid + u.z * 2048 + col0 + bj * HALF + 4);
            const f32x4 b0 = *(const f32x4*)(g.fbias + col0 + bj * HALF) + q0 * sgn, b1 = *(const f32x4*)(g.fbias + col0 + bj * HALF + 4) + q1 * sgn;
            bf16_t* pp0 = g.c0 + (size_t)(u.z * 2048 + u.pm * BM + rloc) * 4096 + 2048 + col0 + bj * HALF;
            u32x4 gt[2][4];
#pragma unroll
            for (int ai = 0; ai < 2; ++ai)
#pragma unroll
                for (int m = 0; m < 4; ++m) gt[ai][m] = *(const u32x4*)(pp0 + (size_t)(ai * HALF + m * 16) * 4096);
#pragma unroll
            for (int ai = 0; ai < 2; ++ai)
#pragma unroll
                for (int m = 0; m < 4; ++m) {
                    float gf[8]; unpack8(gt[ai][m], gf);
                    const f32x4 v0 = acc[ai][bj][m][0] + b0, v1 = acc[ai][bj][m][1] + b1;
                    float r[8];
#pragma unroll
                    for (int e = 0; e < 4; ++e) { r[e] = v0[e] * silu_f(gf[e]); r[4 + e] = v1[e] * silu_f(gf[4 + e]); }
                    *(u32x4*)(pp0 + (size_t)(ai * HALF + m * 16) * 4096) = pack8(r);
                }
        }
    } else {
#pragma unroll
        for (int ai = 0; ai < 2; ++ai) {
            const size_t ro0 = (size_t)(u.pm * BM + rloc + ai * HALF) * 2048 + u.pn * BM + cloc;
            float rr[4][2][8];
            if (g.mode == MODE_RES0) {
                f32x4 t0[4][2], t1[4][2];
#pragma unroll
                for (int m = 0; m < 4; ++m)
#pragma unroll
                    for (int bj = 0; bj < 2; ++bj) { t0[m][bj] = *(const f32x4*)(g.resid + ro0 + (size_t)m * 16 * 2048 + bj * HALF); t1[m][bj] = *(const f32x4*)(g.resid + ro0 + (size_t)m * 16 * 2048 + bj * HALF + 4); }
#pragma unroll
                for (int m = 0; m < 4; ++m)
#pragma unroll
                    for (int bj = 0; bj < 2; ++bj)
#pragma unroll
                        for (int e = 0; e < 4; ++e) { rr[m][bj][e] = t0[m][bj][e]; rr[m][bj][4 + e] = t1[m][bj][e]; }
            } else {
                u32x4 t[4][2];
#pragma unroll
                for (int m = 0; m < 4; ++m)
#pragma unroll
                    for (int bj = 0; bj < 2; ++bj) t[m][bj] = *(const u32x4*)(g.c0 + ro0 + (size_t)m * 16 * 2048 + bj * HALF);
#pragma unroll
                for (int m = 0; m < 4; ++m)
#pragma unroll
                    for (int bj = 0; bj < 2; ++bj) unpack8(t[m][bj], rr[m][bj]);
            }
#pragma unroll
            for (int m = 0; m < 4; ++m)
#pragma unroll
                for (int bj = 0; bj < 2; ++bj) {
#pragma unroll
                    for (int e = 0; e < 4; ++e) { rr[m][bj][e] += acc[ai][bj][m][0][e]; rr[m][bj][4 + e] += acc[ai][bj][m][1][e]; }
                    *(u32x4*)(g.c0 + ro0 + (size_t)m * 16 * 2048 + bj * HALF) = pack8(rr[m][bj]);
                }
        }
    }
}

__device__ __forceinline__ void gemm_phase(const int wbase, LAS unsigned char* lds, const GemmJob& g) {
    const int tid = opaque_tid(wbase), wid = __builtin_amdgcn_readfirstlane(tid >> 6), lane = tid & 63, wr = wid >> 2, wc = wid & 3, fr = lane & 15, fq = lane >> 4;
    const int K = g.K, nt = K / BK;
    unsigned voffA[2], voffB[2];
#pragma unroll
    for (int i = 0; i < 2; ++i) { int R, C; stage_rc(tid * 16 + i * 8192, R, C); const int Rb = (R & ~31) + perm32(R & 31);
        voffA[i] = (unsigned)(R * g.lda + C) * 2u; voffB[i] = (unsigned)(Rb * g.ldb + C) * 2u; }
    const size_t kstep = (size_t)(BK * 2);
    const size_t hstepA = (size_t)HALF * g.lda * 2, hstepB = (size_t)HALF * g.ldb * 2;
    const unsigned ldsw = (unsigned)wid * 1024u;
    const int aoff = lds_byte(wr * 64 + fr, fq * 8), boff = lds_byte(wc * 32 + fr, fq * 8);
#define PG8_SA(b, h) (((b) * 2 + (h)) * HTB)
#define PG8_SB(b, h) ((4 + (b) * 2 + (h)) * HTB)
#define PG8_STAGE(bufoff, gbase, voff) do { _Pragma("unroll") for (int _i = 0; _i < 2; ++_i) \
        __builtin_amdgcn_global_load_lds((const unsigned*)((const char*)(gbase) + (voff)[_i]), (LAS unsigned*)(lds + (bufoff) + ldsw + _i * 8192), 16, 0, 0); } while (0)
#define PG8_LDA(dst, b, h) do { _Pragma("unroll") for (int m = 0; m < 4; ++m) _Pragma("unroll") for (int k = 0; k < 2; ++k) dst[m][k] = *(const LAS bf16x8*)(lds + PG8_SA(b, h) + aoff + m * 2048 + k * 1024); } while (0)
#define PG8_LDB(dst, b, h) do { _Pragma("unroll") for (int n = 0; n < 2; ++n) _Pragma("unroll") for (int k = 0; k < 2; ++k) dst[n][k] = *(const LAS bf16x8*)(lds + PG8_SB(b, h) + boff + n * 2048 + k * 1024); } while (0)
#define PG8_MMA(ai, bj, At, Bt) do { __builtin_amdgcn_s_setprio(1); _Pragma("unroll") for (int m = 0; m < 4; ++m) _Pragma("unroll") for (int n = 0; n < 2; ++n) _Pragma("unroll") for (int k = 0; k < 2; ++k) \
        acc[ai][bj][m][n] = __builtin_amdgcn_mfma_f32_16x16x32_bf16(Bt[n][k], At[m][k], acc[ai][bj][m][n], 0, 0, 0); __builtin_amdgcn_s_setprio(0); } while (0)
#define PG8_WAIT_V(n) asm volatile("s_waitcnt vmcnt(" #n ")" ::: "memory")
#define PG8_WAIT_L(n) asm volatile("s_waitcnt lgkmcnt(" #n ")" ::: "memory")
#define PG8_BAR __builtin_amdgcn_s_barrier()
#define PG8_SCHED __builtin_amdgcn_sched_barrier(0)
    Unit cur, nxt; int ui = 0;
    if (!next_unit(g, 0, cur)) return;
    f32x4 acc[2][2][4][2];
#pragma unroll
    for (int a = 0; a < 2; ++a)
#pragma unroll
        for (int b = 0; b < 2; ++b)
#pragma unroll
            for (int m = 0; m < 4; ++m)
#pragma unroll
                for (int n = 0; n < 2; ++n) acc[a][b][m][n] = (f32x4){0.f, 0.f, 0.f, 0.f};
    bf16x8 At[4][2], B0[2][2], B1[2][2];
    const char* cA = g.A + (size_t)cur.z * g.strideAz + (size_t)cur.pm * 2 * hstepA;
    const char* cB = g.Bt + (size_t)cur.z * g.strideBz + (size_t)cur.pn * 2 * hstepB + (size_t)cur.pm * g.strideBpm;
    PG8_STAGE(PG8_SB(0, 0), cB, voffB); PG8_STAGE(PG8_SA(0, 0), cA, voffA); PG8_STAGE(PG8_SB(0, 1), cB + hstepB, voffB); PG8_STAGE(PG8_SA(0, 1), cA + hstepA, voffA);
    if (wr == 1) PG8_BAR;
    PG8_WAIT_V(4); PG8_BAR;
    PG8_STAGE(PG8_SB(1, 0), cB + kstep, voffB); PG8_STAGE(PG8_SA(1, 0), cA + kstep, voffA); PG8_STAGE(PG8_SB(1, 1), cB + hstepB + kstep, voffB);
    PG8_WAIT_V(6); PG8_BAR;
    for (;;) {
        const bool has_next = next_unit(g, ui + 1, nxt);
        const char* nA = has_next ? g.A + (size_t)nxt.z * g.strideAz + (size_t)nxt.pm * 2 * hstepA : cA;
        const char* nB = has_next ? g.Bt + (size_t)nxt.z * g.strideBz + (size_t)nxt.pn * 2 * hstepB + (size_t)nxt.pm * g.strideBpm : cB;
        for (int t = 0; t < nt; t += 2) {
            const bool last = (t == nt - 2);
            const char* a1 = cA + (size_t)(t + 1) * kstep;
            const char* a2 = last ? nA : cA + (size_t)(t + 2) * kstep; const char* b2 = last ? nB : cB + (size_t)(t + 2) * kstep;
            const char* a3 = a2 + kstep; const char* b3 = b2 + kstep;
            PG8_LDB(B0, 0, 0); PG8_SCHED; PG8_LDA(At, 0, 0); PG8_STAGE(PG8_SA(1, 1), a1 + hstepA, voffA);
            PG8_WAIT_L(8); PG8_BAR; PG8_WAIT_L(0); PG8_MMA(0, 0, At, B0); PG8_BAR; PG8_SCHED;
            PG8_LDB(B1, 0, 1); PG8_STAGE(PG8_SB(0, 0), b2, voffB);
            PG8_BAR; PG8_WAIT_L(0); PG8_MMA(0, 1, At, B1); PG8_BAR;
            PG8_LDA(At, 0, 1); PG8_STAGE(PG8_SA(0, 0), a2, voffA);
            PG8_BAR; PG8_WAIT_L(0); PG8_MMA(1, 0, At, B0); PG8_BAR; PG8_SCHED;
            PG8_STAGE(PG8_SB(0, 1), b2 + hstepB, voffB);
            PG8_WAIT_V(6); PG8_BAR; PG8_MMA(1, 1, At, B1); PG8_BAR;
            PG8_LDB(B0, 1, 0); PG8_SCHED; PG8_LDA(At, 1, 0); PG8_STAGE(PG8_SA(0, 1), a2 + hstepA, voffA);
            PG8_WAIT_L(8); PG8_BAR; PG8_WAIT_L(0); PG8_MMA(0, 0, At, B0); PG8_BAR; PG8_SCHED;
            PG8_LDB(B1, 1, 1); PG8_STAGE(PG8_SB(1, 0), b3, voffB);
            PG8_BAR; PG8_WAIT_L(0); PG8_MMA(0, 1, At, B1); PG8_BAR;
            PG8_LDA(At, 1, 1); PG8_STAGE(PG8_SA(1, 0), a3, voffA);
            PG8_BAR; PG8_WAIT_L(0); PG8_MMA(1, 0, At, B0); PG8_BAR; PG8_SCHED;
            PG8_STAGE(PG8_SB(1, 1), b3 + hstepB, voffB);
            PG8_WAIT_V(6); PG8_BAR; PG8_MMA(1, 1, At, B1); PG8_BAR;
        }
        gemm_epilogue(acc, g, cur, wr, wc, fr, fq);
        if (!has_next) break;
#pragma unroll
        for (int a = 0; a < 2; ++a)
#pragma unroll
            for (int b = 0; b < 2; ++b)
#pragma unroll
                for (int m = 0; m < 4; ++m)
#pragma unroll
                    for (int n = 0; n < 2; ++n) acc[a][b][m][n] = (f32x4){0.f, 0.f, 0.f, 0.f};
        cur = nxt; cA = nA; cB = nB; ++ui;
    }
    PG8_WAIT_V(0);
    if (wr == 0) PG8_BAR;
    PG8_BAR;
#undef PG8_SA
#undef PG8_SB
#undef PG8_STAGE
#undef PG8_LDA
#undef PG8_LDB
#undef PG8_MMA
#undef PG8_WAIT_V
#undef PG8_WAIT_L
#undef PG8_BAR
#undef PG8_SCHED
}

__device__ __forceinline__ int pair_row(int n) {
    if (n >= 8192) return n;
    const int seg = n >> 11, ch = n & 2047, t = ch >> 7, j = ch & 127;
    return ((seg & 1) ? 4096 : 0) + 256 * t + ((seg & 2) ? 128 : 0) + j;
}
template <bool PAIRMAP = false>
__device__ __forceinline__ void transpose_cvt(const int wbase, LAS unsigned char* lds, const float* __restrict__ src, int Kr, int Nc, bf16_t* __restrict__ dst) {
    constexpr int TP = 544;
    const int tid = opaque_tid(wbase), wid = tid >> 6, lane = tid & 63;
    const int npn = (Nc + 255) / 256, npk = Kr / 64, npan = npn * npk;
    const int kr = tid >> 3, q = tid & 7;
    const int g = lane >> 4, qq = (lane & 15) >> 2, pp = lane & 3;
    f32x4 v[8], vn[8];
    auto load_panel = [&](int idx, f32x4 (&dstv)[8]) {
        idx = idx < npan ? idx : npan - 1;
        const int n0 = (idx % npn) * 256, k0 = (idx / npn) * 64;
#pragma unroll
        for (int j = 0; j < 8; ++j) {
            int n = n0 + (q + 8 * j) * 4; n = n < Nc ? n : Nc - 4;
            dstv[j] = *(const f32x4*)(src + (size_t)(k0 + kr) * Nc + n);
        }
    };
    load_panel(blockIdx.x, v);
    for (int idx = blockIdx.x; idx < npan; idx += gridDim.x) {
        const int n0 = (idx % npn) * 256, k0 = (idx / npn) * 64;
        load_panel(idx + gridDim.x, vn);
        __syncthreads();
#pragma unroll
        for (int j = 0; j < 8; ++j) {
            u32x2 o; o[0] = cvt_pk_bf16(v[j][0], v[j][1]); o[1] = cvt_pk_bf16(v[j][2], v[j][3]);
            *(LAS u32x2*)(lds + kr * TP + (q + 8 * j) * 8) = o;
        }
        __syncthreads();
#pragma unroll
        for (int it = 0; it < 4; ++it) {
            const int f = wid * 4 + it, r0 = (f & 1) * 32, c0 = (f >> 1) * 16;
            LAS unsigned char* a0 = lds + (r0 + 8 * g + qq) * TP + c0 * 2 + 8 * pp;
            const s16x4 lo = __builtin_amdgcn_ds_read_tr16_b64_v4i16((LAS s16x4*)a0);
            const s16x4 hi = __builtin_amdgcn_ds_read_tr16_b64_v4i16((LAS s16x4*)(a0 + 4 * TP));
            const int n = n0 + c0 + (lane & 15);
            union { s16x4 h[2]; u32x4 u; } cv; cv.h[0] = lo; cv.h[1] = hi;
            if (n < Nc) *(u32x4*)(dst + (size_t)(PAIRMAP ? pair_row(n) : n) * Kr + k0 + r0 + 8 * g) = cv.u;
        }
#pragma unroll
        for (int j = 0; j < 8; ++j) v[j] = vn[j];
    }
    __syncthreads();
}

__device__ __forceinline__ void rmsnorm_to_bf16(const int wbase, const float* __restrict__ x, const float* __restrict__ w, bf16_t* __restrict__ out) {
    const int tid_ = opaque_tid(wbase); const int lane = tid_ & 63, wv = blockIdx.x * 8 + (tid_ >> 6), nwv = gridDim.x * 8;
    for (int row = wv; row < TOK; row += nwv) {
        f32x4 v[8]; float ss = 0.f;
#pragma unroll
        for (int i = 0; i < 8; ++i) { v[i] = *(const f32x4*)(x + (size_t)row * DM + i * 256 + lane * 4); ss += v[i][0] * v[i][0] + v[i][1] * v[i][1] + v[i][2] * v[i][2] + v[i][3] * v[i][3]; }
#pragma unroll
        for (int s = 32; s >= 1; s >>= 1) ss += __shfl_xor(ss, s);
        const float rs = rsqrtf(ss * (1.0f / DM) + EPS);
#pragma unroll
        for (int i = 0; i < 8; ++i) {
            const f32x4 w4 = *(const f32x4*)(w + i * 256 + lane * 4);
            u32x2 o; o[0] = cvt_pk_bf16(v[i][0] * rs * w4[0], v[i][1] * rs * w4[1]); o[1] = cvt_pk_bf16(v[i][2] * rs * w4[2], v[i][3] * rs * w4[3]);
            *(u32x2*)(out + (size_t)row * DM + i * 256 + lane * 4) = o;
        }
    }
}

template <bool TO_F32> __device__ __forceinline__ void rmsnorm_from_bf16(const int wbase, const bf16_t* __restrict__ x, const float* __restrict__ w, void* __restrict__ outp) {
    const int tid_ = opaque_tid(wbase); const int lane = tid_ & 63, wv = blockIdx.x * 8 + (tid_ >> 6), nwv = gridDim.x * 8;
    float nw[4][8];
#pragma unroll
    for (int i = 0; i < 4; ++i) {
        const int c8 = (i * 64 + lane) * 8;
        const f32x4 w0 = *(const f32x4*)(w + c8), w1 = *(const f32x4*)(w + c8 + 4);
#pragma unroll
        for (int e = 0; e < 8; ++e) nw[i][e] = e < 4 ? w0[e & 3] : w1[e & 3];
    }
    for (int row = wv; row < TOK; row += nwv) {
        float v[4][8]; float ss = 0.f;
#pragma unroll
        for (int i = 0; i < 4; ++i) {
            unpack8(*(const u32x4*)(x + (size_t)row * DM + (i * 64 + lane) * 8), v[i]);
#pragma unroll
            for (int e = 0; e < 8; ++e) ss += v[i][e] * v[i][e];
        }
#pragma unroll
        for (int s = 32; s >= 1; s >>= 1) ss += __shfl_xor(ss, s);
        const float rs = rsqrtf(ss * (1.0f / DM) + EPS);
#pragma unroll
        for (int i = 0; i < 4; ++i) {
            const int c8 = (i * 64 + lane) * 8;
            float o[8];
#pragma unroll
            for (int e = 0; e < 8; ++e) o[e] = v[i][e] * rs * nw[i][e];
            if (TO_F32) {
                float* op = (float*)outp + (size_t)row * DM + c8;
                *(f32x4*)op = (f32x4){o[0], o[1], o[2], o[3]}; *(f32x4*)(op + 4) = (f32x4){o[4], o[5], o[6], o[7]};
            } else *(u32x4*)((bf16_t*)outp + (size_t)row * DM + c8) = pack8(o);
        }
    }
}

__device__ __forceinline__ void build_dft(const int wbase, bf16_t* __restrict__ dft) {
    const size_t gt = (size_t)blockIdx.x * 512 + opaque_tid(wbase), nth = (size_t)gridDim.x * 512;
    for (size_t pidx = gt; pidx < (size_t)2048 * 256; pidx += nth) {
        const int k = (int)(pidx >> 8), j0 = (int)(pidx & 255) * 8;
        float f[8];
#pragma unroll
        for (int e = 0; e < 8; ++e) {
            const int j = j0 + e, l = j & 1023;
            const float ang = (float)((k * l) & 2047) * (1.0f / 1024.0f);
            f[e] = (j < 1024) ? cospif(ang) : -sinpif(ang);
        }
        *(u32x4*)(dft + (size_t)k * 2048 + j0) = pack8(f);
    }
}

__device__ __forceinline__ void fold_phase(const int wbase, const Params& p) {
    const bf16_t* bu = (const bf16_t*)(p.ws + WS_S0); bf16_t* uf = (bf16_t*)(p.ws + WS_UF);
    const bf16_t* w12 = (const bf16_t*)(p.ws + WS_W12); float* p1024 = (float*)(p.ws + WS_P1024);
    const size_t gt = (size_t)blockIdx.x * 512 + opaque_tid(wbase), nth = (size_t)gridDim.x * 512;
    for (size_t pc = gt; pc < (size_t)8 * 1024 * 256; pc += nth) {
        const int c8 = (int)(pc & 255) * 8, l = (int)(pc >> 8) & 1023, b = (int)(pc >> 18);
        float a[8], m[8], ue[8], uo[8];
        unpack8(*(const u32x4*)(bu + (size_t)(b * 2048 + l) * 2048 + c8), a);
        if (l > 0) {
            unpack8(*(const u32x4*)(bu + (size_t)(b * 2048 + 2048 - l) * 2048 + c8), m);
#pragma unroll
            for (int e = 0; e < 8; ++e) { ue[e] = a[e] + m[e]; uo[e] = a[e] - m[e]; }
        } else {
#pragma unroll
            for (int e = 0; e < 8; ++e) { ue[e] = a[e]; uo[e] = 0.f; }
        }
        *(u32x4*)(uf + (size_t)(b * 1024 + l) * 2048 + c8) = pack8(ue);
        *(u32x4*)(uf + (size_t)(8192 + b * 1024 + l) * 2048 + c8) = pack8(uo);
    }
    if (gt < 16384) {
        const int b = (int)(gt >> 11), ch = (int)(gt & 2047), g = ch >> 8, d = ch & 255;
        const bf16_t* up = bu + (size_t)(b * 2048 + 1024) * 2048 + g * 256; const bf16_t* wp = w12 + (size_t)g * 512 * 256 + (size_t)d * 256;
        float acc = 0.f;
#pragma unroll 4
        for (int c = 0; c < 256; c += 8) {
            float u[8], w[8]; unpack8(*(const u32x4*)(up + c), u); unpack8(*(const u32x4*)(wp + c), w);
#pragma unroll
            for (int e = 0; e < 8; ++e) acc += u[e] * w[e];
        }
        p1024[gt] = acc;
    }
}

__device__ __forceinline__ void build_w12(const int wbase, LAS unsigned char* lds, const float* __restrict__ fw, bf16_t* __restrict__ w12) {
    LAS float* fwl = (LAS float*)lds;
    LAS float* ctab = (LAS float*)(lds + 65536); LAS float* stab = ctab + 256;
    const int tid = opaque_tid(wbase), wid = tid >> 6, lane = tid & 63;
    const float scale = 1.0f / sqrtf(2048.0f * 256.0f);
    for (int task = blockIdx.x; task < 256; task += gridDim.x) {
        const int g = task >> 5, d0 = ((task >> 3) & 3) * 64, c0 = (task & 7) * 32;
        __syncthreads();
        if (tid < 256) { const float ang = (float)tid * (1.0f / 128.0f); ctab[tid] = cospif(ang); stab[tid] = sinpif(ang); }
#pragma unroll
        for (int j = 0; j < 8; ++j) {
            const int m = j * 32 + (tid >> 4), dd = (tid & 15) * 4;
            *(LAS f32x4*)(fwl + m * 64 + dd) = *(const f32x4*)(fw + (size_t)g * 65536 + (size_t)m * 256 + d0 + dd);
        }
        __syncthreads();
        const int cb = c0 + wid * 4;
        float ac[4] = {0.f, 0.f, 0.f, 0.f}, as[4] = {0.f, 0.f, 0.f, 0.f};
#pragma unroll 8
        for (int m = 0; m < 256; ++m) {
            const float v = fwl[m * 64 + lane];
#pragma unroll
            for (int cc = 0; cc < 4; ++cc) { const int ti = (m * (cb + cc)) & 255; ac[cc] += ctab[ti] * v; as[cc] += stab[ti] * v; }
        }
        bf16_t* o = w12 + (size_t)g * 512 * 256 + (size_t)(d0 + lane) * 256 + cb;
        u32x2 oc, os; oc[0] = cvt_pk_bf16(ac[0] * scale, ac[1] * scale); oc[1] = cvt_pk_bf16(ac[2] * scale, ac[3] * scale);
        os[0] = cvt_pk_bf16(as[0] * scale, as[1] * scale); os[1] = cvt_pk_bf16(as[2] * scale, as[3] * scale);
        *(u32x2*)o = oc; *(u32x2*)(o + 256 * 256) = os;
    }
    __syncthreads();
}

__device__ __forceinline__ void zero_fill16(const int wbase, unsigned char* p, size_t bytes) {
    const size_t gt = (size_t)blockIdx.x * 512 + opaque_tid(wbase), nth = (size_t)gridDim.x * 512;
    for (size_t i = gt; i < bytes / 16; i += nth) *(u32x4*)(p + i * 16) = (u32x4){0u, 0u, 0u, 0u};
}

__device__ __forceinline__ void gla_phase(const int wbase, LAS unsigned char* lds, const Params& p) {
    constexpr int G_OFF = 0, QIN_OFF = 16384, KIN_OFF = 25728, KET_OFF = 35072, VT_OFF = 44416, SC_OFF = 53760, EB_OFF = 56320;
    constexpr int TLD = 80;
    const int tid = opaque_tid(wbase), wid = __builtin_amdgcn_readfirstlane(tid >> 6), lane = tid & 63, fr = lane & 15, fq = lane >> 4;
    const int r = tid >> 4, c8 = (tid & 15) * 8;
    const bf16_t* qb = (const bf16_t*)(p.ws + WS_S0); const bf16_t* vb = (const bf16_t*)(p.ws + WS_S1);
    for (int item = blockIdx.x; item < 256; item += gridDim.x) {
        const int xcd = item & 7, slot = item >> 3, dir = slot & 1, bh = (slot >> 1) * 8 + xcd, b = bh >> 4, h = bh & 15;
        bf16_t* zb = (bf16_t*)(p.ws + (dir ? WS_S3 : WS_S2));
        float lb[8], oml[8];
#pragma unroll
        for (int e = 0; e < 8; ++e) {
            const int ch = h * 128 + c8 + e;
            const float l0 = p.lb_logits[ch], l1 = p.lb_logits[2048 + ch], l2 = p.lb_logits[4096 + ch];
            const float mx = fmaxf(l0, fmaxf(l1, l2)), e0 = __expf(l0 - mx), e1 = __expf(l1 - mx), e2 = __expf(l2 - mx);
            lb[e] = e0 / (e0 + e1 + e2); oml[e] = 1.0f - lb[e];
        }
        f32x4 accS[8];
#pragma unroll
        for (int i = 0; i < 8; ++i) accS[i] = (f32x4){0.f, 0.f, 0.f, 0.f};
        __syncthreads();
        if (tid < 64) *(LAS u32x2*)(lds + SC_OFF + (tid >> 2) * TLD + 32 + (tid & 3) * 8) = (u32x2){0u, 0u};
        const size_t colo = (size_t)h * 128 + c8;
        auto row_of = [&](int c, int rr) -> size_t { const int tt = c * 32 + rr; const int t = dir ? (SEQ - 1 - tt) : tt; return (size_t)(b * SEQ + t) * DM; };
        u32x4 rq, rv, rz;
        { const size_t ro = row_of(0, r) + colo; rq = *(const u32x4*)(qb + ro); rv = *(const u32x4*)(vb + ro); rz = *(const u32x4*)(zb + ro); }
        for (int c = 0; c < SEQ / 32; ++c) {
            float qf[8], zf[8], kf[8];
            unpack8(rq, qf); unpack8(rz, zf);
            const u32x4 vcur = rv;
            {
                float gf[8];
#pragma unroll
                for (int e = 0; e < 8; ++e) {
                    const float s = 1.0f / (1.0f + __expf(-zf[e]));
                    const float f = lb[e] + oml[e] * s;
                    gf[e] = __logf(f); kf[e] = oml[e] * (1.0f - s);
                }
                *(LAS f32x4*)(lds + G_OFF + r * 512 + c8 * 4) = (f32x4){gf[0], gf[1], gf[2], gf[3]};
                *(LAS f32x4*)(lds + G_OFF + r * 512 + c8 * 4 + 16) = (f32x4){gf[4], gf[5], gf[6], gf[7]};
            }
            if (c + 1 < SEQ / 32) { const size_t ro = row_of(c + 1, r) + colo; rq = *(const u32x4*)(qb + ro); rv = *(const u32x4*)(vb + ro); rz = *(const u32x4*)(zb + ro); }
            __syncthreads();
            {
                const int ccol = tid >> 2, part = tid & 3;
                LAS float* gp = (LAS float*)(lds + G_OFF + part * 8 * 512 + ccol * 4);
                float pr[8]; float run = 0.f;
#pragma unroll
                for (int rr = 0; rr < 8; ++rr) { run += gp[rr * 128]; pr[rr] = run; }
                const int ti_ = __builtin_bit_cast(int, run);
                const float t1 = __builtin_bit_cast(float, __builtin_amdgcn_update_dpp(0, ti_, 0x111, 0xf, 0xf, false));
                const float t2 = __builtin_bit_cast(float, __builtin_amdgcn_update_dpp(0, ti_, 0x112, 0xf, 0xf, false));
                const float t3 = __builtin_bit_cast(float, __builtin_amdgcn_update_dpp(0, ti_, 0x113, 0xf, 0xf, false));
                const float off = (part >= 1 ? t1 : 0.f) + (part >= 2 ? t2 : 0.f) + (part >= 3 ? t3 : 0.f);
#pragma unroll
                for (int rr = 0; rr < 8; ++rr) gp[rr * 128] = pr[rr] + off;
                if (part == 3) *(LAS float*)(lds + EB_OFF + ccol * 4) = __expf(run + off);
            }
            __syncthreads();
            {
                const f32x4 b0 = *(LAS f32x4*)(lds + G_OFF + r * 512 + c8 * 4), b1 = *(LAS f32x4*)(lds + G_OFF + r * 512 + c8 * 4 + 16);
                const f32x4 l0 = *(LAS f32x4*)(lds + EB_OFF + c8 * 4), l1 = *(LAS f32x4*)(lds + EB_OFF + c8 * 4 + 16);
                float qi[8], ki[8], ke[8];
#pragma unroll
                for (int e = 0; e < 8; ++e) {
                    const float bc = e < 4 ? b0[e & 3] : b1[e & 3], ebl = e < 4 ? l0[e & 3] : l1[e & 3];
                    qi[e] = qf[e] * __expf(bc); ki[e] = kf[e] * __expf(-bc); ke[e] = ki[e] * ebl;
                }
                *(LAS u32x4*)(lds + QIN_OFF + rowaddr(r) + c8 * 2) = pack8(qi);
                *(LAS u32x4*)(lds + KIN_OFF + rowaddr(r) + c8 * 2) = pack8(ki);
                *(LAS u32x4*)(lds + KET_OFF + rowaddr(r) + c8 * 2) = pack8(ke);
                *(LAS u32x4*)(lds + VT_OFF + rowaddr(r) + c8 * 2) = vcur;
            }
            __syncthreads();
            if (wid < 3) {
                const int mt = wid >= 1 ? 1 : 0, ntl = wid == 2 ? 1 : 0;
                f32x4 sacc = (f32x4){0.f, 0.f, 0.f, 0.f};
#pragma unroll
                for (int kk = 0; kk < 4; ++kk) {
                    const bf16x8 a = lds_b128(lds + KIN_OFF + rowaddr(ntl * 16 + fr) + (kk * 32 + fq * 8) * 2);
                    const bf16x8 bq = lds_b128(lds + QIN_OFF + rowaddr(mt * 16 + fr) + (kk * 32 + fq * 8) * 2);
                    sacc = MFMA16(a, bq, sacc);
                }
                const int i = mt * 16 + fr, j0 = ntl * 16 + fq * 4;
                u32x2 o; o[0] = cvt_pk_bf16(j0 + 0 <= i ? sacc[0] : 0.f, j0 + 1 <= i ? sacc[1] : 0.f); o[1] = cvt_pk_bf16(j0 + 2 <= i ? sacc[2] : 0.f, j0 + 3 <= i ? sacc[3] : 0.f);
                *(LAS u32x2*)(lds + SC_OFF + i * TLD + j0 * 2) = o;
            }
            f32x4 oacc[2]; oacc[0] = (f32x4){0.f, 0.f, 0.f, 0.f}; oacc[1] = oacc[0];
#pragma unroll
            for (int pp = 0; pp < 4; ++pp) {
                const bf16x8 sa = pack_acc2(accS[2 * pp], accS[2 * pp + 1]);
#pragma unroll
                for (int mt = 0; mt < 2; ++mt) {
                    LAS unsigned char* qp = lds + QIN_OFF + rowaddr(mt * 16 + fr) + (pp * 32 + fq * 4) * 2;
                    const bf16x8 bq = lds_2xb64(qp, qp + 32);
                    oacc[mt] = MFMA16(sa, bq, oacc[mt]);
                }
            }
            __syncthreads();
            {
                const bf16x8 va = lds_tr_frag(lds + VT_OFF, 0, wid * 16, lane);
#pragma unroll
                for (int mt = 0; mt < 2; ++mt) {
                    const bf16x8 sb = lds_b128(lds + SC_OFF + (mt * 16 + fr) * TLD + fq * 16);
                    oacc[mt] = MFMA16(va, sb, oacc[mt]);
                    u32x2 o; o[0] = cvt_pk_bf16(oacc[mt][0], oacc[mt][1]); o[1] = cvt_pk_bf16(oacc[mt][2], oacc[mt][3]);
                    *(u32x2*)(zb + row_of(c, mt * 16 + fr) + (size_t)h * 128 + wid * 16 + fq * 4) = o;
                }
#pragma unroll
                for (int kt = 0; kt < 8; ++kt) {
                    const f32x4 e4 = *(LAS f32x4*)(lds + EB_OFF + (kt * 16 + fq * 4) * 4);
                    accS[kt] = accS[kt] * e4;
                    accS[kt] = MFMA16(lds_tr_frag(lds + KET_OFF, 0, kt * 16, lane), va, accS[kt]);
                }
            }
        }
        __syncthreads();
    }
}

__device__ __forceinline__ void post_a_phase(const int wbase, const Params& p) {
    const bf16_t* of = (const bf16_t*)(p.ws + WS_S2); const bf16_t* ob = (const bf16_t*)(p.ws + WS_S3);
    bf16_t* mix = (bf16_t*)p.out;
    const size_t gt = (size_t)blockIdx.x * 512 + opaque_tid(wbase), nth = (size_t)gridDim.x * 512;
    for (size_t pc = gt; pc < (size_t)TOK * 256; pc += 2 * nth) {
        u32x4 ra[2], rb[2], rg[2];
#pragma unroll
        for (int u = 0; u < 2; ++u) {
            const size_t q = pc + u * nth; const size_t tok = q >> 8; const int c8 = (int)(q & 255) * 8;
            ra[u] = *(const u32x4*)(of + tok * DM + c8); rb[u] = *(const u32x4*)(ob + tok * DM + c8); rg[u] = *(const u32x4*)(mix + tok * 4096 + c8);
        }
#pragma unroll
        for (int u = 0; u < 2; ++u) {
            const size_t q = pc + u * nth; const size_t tok = q >> 8; const int c8 = (int)(q & 255) * 8;
            float a[8], bb[8], gte[8];
            unpack8(ra[u], a); unpack8(rb[u], bb); unpack8(rg[u], gte);
            float ss = 0.f;
#pragma unroll
            for (int e = 0; e < 8; ++e) { a[e] += bb[e]; ss += a[e] * a[e]; }
            ss += __shfl_xor(ss, 1); ss += __shfl_xor(ss, 2); ss += __shfl_xor(ss, 4); ss += __shfl_xor(ss, 8);
            const float rs = rsqrtf(ss * (1.0f / 128.0f) + EPS);
            const f32x4 w0 = *(const f32x4*)(p.hgrn_norm_w + c8), w1 = *(const f32x4*)(p.hgrn_norm_w + c8 + 4);
            float o[8];
#pragma unroll
            for (int e = 0; e < 8; ++e) o[e] = a[e] * rs * (e < 4 ? w0[e & 3] : w1[e & 3]) * silu_f(gte[e]);
            *(u32x4*)(mix + tok * 4096 + c8) = pack8(o);
        }
    }
}

__device__ __forceinline__ void conv_c_phase(const int wbase, const Params& p) {
    const bf16_t* uu = (const bf16_t*)(p.ws + WS_CIN);
    bf16_t* mix = (bf16_t*)p.out;
    const size_t gt = (size_t)blockIdx.x * 512 + opaque_tid(wbase), nth = (size_t)gridDim.x * 512;
    for (size_t pc0 = gt; pc0 < (size_t)TOK * 256; pc0 += 2 * nth) {
        u32x4 ru[2][3], rw[2];
#pragma unroll
        for (int h = 0; h < 2; ++h) {
            const size_t pc = pc0 + h * nth; const size_t tok = pc >> 8; const int c8 = (int)(pc & 255) * 8; const int t = (int)(tok & (SEQ - 1));
#pragma unroll
            for (int k = 0; k < 3; ++k) {
                const int tt = t + k - 1;
                ru[h][k] = (tt >= 0 && tt < SEQ) ? *(const u32x4*)(uu + (tok + k - 1) * DM + c8) : (u32x4){0u, 0u, 0u, 0u};
            }
            rw[h] = *(const u32x4*)(mix + tok * 4096 + c8);
        }
#pragma unroll
        for (int h = 0; h < 2; ++h) {
            const size_t pc = pc0 + h * nth; const size_t tok = pc >> 8; const int c8 = (int)(pc & 255) * 8;
            float acc[8];
#pragma unroll
            for (int e = 0; e < 8; ++e) acc[e] = 0.f;
#pragma unroll
            for (int k = 0; k < 3; ++k) {
                float u[8]; unpack8(ru[h][k], u);
                const f32x4 w0 = *(const f32x4*)(p.sconv_w + k * DM + c8), w1 = *(const f32x4*)(p.sconv_w + k * DM + c8 + 4);
#pragma unroll
                for (int e = 0; e < 8; ++e) acc[e] += u[e] * (e < 4 ? w0[e & 3] : w1[e & 3]);
            }
            float wv[8]; unpack8(rw[h], wv);
            float o[8];
#pragma unroll
            for (int e = 0; e < 8; ++e) o[e] = wv[e] * acc[e];
            *(u32x4*)(mix + tok * 4096 + c8) = pack8(o);
        }
    }
}

__device__ __forceinline__ void preconv_phase(const int wbase, const Params& p) {
    const bf16_t* xbc = (const bf16_t*)(p.ws + WS_XBC); bf16_t* xact = (bf16_t*)(p.ws + WS_XACT); bf16_t* bcact = (bf16_t*)(p.ws + WS_BCACT);
    const size_t gt = (size_t)blockIdx.x * 512 + opaque_tid(wbase), nth = (size_t)gridDim.x * 512;
    for (size_t pc = gt; pc < (size_t)(TOK / 4) * 384; pc += nth) {
        const int cg = (int)(pc % 384), c8 = cg * 8; const size_t tok0 = (pc / 384) * 4; const int t0 = (int)(tok0 & (SEQ - 1));
        u32x4 raw[6];
#pragma unroll
        for (int j = 0; j < 6; ++j) { const int t = t0 - 1 + j; raw[j] = (t >= 0 && t < SEQ) ? *(const u32x4*)(xbc + (tok0 + j - 1) * 3072 + c8) : (u32x4){0u, 0u, 0u, 0u}; }
        float w0[8], w1[8], w2[8], cb[8];
        { const f32x4 a0 = *(const f32x4*)(p.ssd_conv_w + c8), a1 = *(const f32x4*)(p.ssd_conv_w + c8 + 4), b0 = *(const f32x4*)(p.ssd_conv_w + 3072 + c8), b1 = *(const f32x4*)(p.ssd_conv_w + 3072 + c8 + 4),
                      c0 = *(const f32x4*)(p.ssd_conv_w + 6144 + c8), c1 = *(const f32x4*)(p.ssd_conv_w + 6144 + c8 + 4), d0 = *(const f32x4*)(p.ssd_conv_b + c8), d1 = *(const f32x4*)(p.ssd_conv_b + c8 + 4);
#pragma unroll
          for (int e = 0; e < 8; ++e) { w0[e] = e < 4 ? a0[e & 3] : a1[e & 3]; w1[e] = e < 4 ? b0[e & 3] : b1[e & 3]; w2[e] = e < 4 ? c0[e & 3] : c1[e & 3]; cb[e] = e < 4 ? d0[e & 3] : d1[e & 3]; } }
        float prev[8], cur[8], nxt[8], val[8];
        unpack8(raw[0], prev); unpack8(raw[1], cur);
#pragma unroll
        for (int j = 0; j < 4; ++j) {
            unpack8(raw[j + 2], nxt);
#pragma unroll
            for (int e = 0; e < 8; ++e) { val[e] = silu_f(w0[e] * prev[e] + w1[e] * cur[e] + w2[e] * nxt[e] + cb[e]); prev[e] = cur[e]; cur[e] = nxt[e]; }
            if (c8 < 2048) *(u32x4*)(xact + (tok0 + j) * 2048 + c8) = pack8(val);
            else *(u32x4*)(bcact + (tok0 + j) * 1024 + (c8 - 2048)) = pack8(val);
        }
    }
}

__device__ __forceinline__ void ssd_phase(const int wbase, LAS unsigned char* lds, const Params& p) {
    constexpr int CS_OFF = 0, BS_OFF = 18560, XS_OFF = 37120, XWS_OFF = 55680, MT_OFF = 74240, ACUM_OFF = 92672, DTV_OFF = 93696;
    constexpr int JLD = 144, HDS = 64 * 144;
    const int tid = opaque_tid(wbase), wid = __builtin_amdgcn_readfirstlane(tid >> 6), lane = tid & 63, fr = lane & 15, fq = lane >> 4;
    const int hd = wid >> 2, wv = wid & 3;
    const bf16_t* xbc = (const bf16_t*)(p.ws + WS_XBC); const bf16_t* dtb = (const bf16_t*)(p.ws + WS_DT);
    for (int item = blockIdx.x; item < 256; item += gridDim.x) {
        const int xcd = item & 7, slot = item >> 3, bg = xcd * 4 + (slot >> 3), b = bg >> 2, grp = bg & 3, sub = slot & 7, dir = sub & 1, pair = sub >> 1;
        const int head0 = grp * 8 + pair * 2, head = head0 + hd;
        bf16_t* yb = (bf16_t*)(p.ws + (dir ? WS_YB : WS_YF));
        const int cg = tid & 15, lrow = tid >> 4;
        const bf16_t* xact = (const bf16_t*)(p.ws + WS_XACT); const bf16_t* bcact = (const bf16_t*)(p.ws + WS_BCACT);
        const float dtbias = p.dt_bias[dir * 32 + head], Acoef = -__expf(p.a_log[dir * 32 + head]);
        f32x4 accS[8];
#pragma unroll
        for (int i = 0; i < 8; ++i) accS[i] = (f32x4){0.f, 0.f, 0.f, 0.f};
        __syncthreads();
        if (tid < 256) { const int hh = tid >> 7, which = (tid >> 6) & 1, rr = (tid >> 2) & 15, cq = tid & 3;
            *(LAS u32x2*)(lds + MT_OFF + hh * HDS + (which * 32 + rr) * JLD + (which * 32 + 16 + cq * 4) * 2) = (u32x2){0u, 0u}; }
        u32x4 raw[6]; unsigned rawdt = 0;
        auto load_chunk = [&](int c) {
            const int t0 = dir ? (SEQ - 64 * (c + 1)) : 64 * c;
            if (wv == 0) { const int t = dir ? (t0 + 63 - lane) : (t0 + lane); rawdt = dtb[(size_t)(b * SEQ + t) * 256 + dir * 32 + head]; }
#pragma unroll
            for (int j = 0; j < 6; ++j) {
                const int i = lrow + 32 * (j & 1), t = t0 + (dir ? 63 - i : i);
                const size_t row = (size_t)(b * SEQ + t);
                raw[j] = (j < 2) ? *(const u32x4*)(xact + row * 2048 + head0 * 64 + cg * 8)
                                 : *(const u32x4*)(bcact + row * 1024 + (j < 4 ? 0 : 512) + grp * 128 + cg * 8);
            }
        };
        load_chunk(0);
        {
            const int t00 = dir ? (SEQ - 64) : 0;
#pragma unroll
            for (int it = 0; it < 4; ++it) { const int i = it * 16 + fr, tt = dir ? 63 - i : i;
                *(u32x2*)(yb + (size_t)(b * SEQ + t00 + tt) * DM + head * 64 + wv * 16 + fq * 4) = (u32x2){0u, 0u}; }
        }
        for (int c = 0; c < SEQ / 64; ++c) {
            const int t0 = dir ? (SEQ - 64 * (c + 1)) : 64 * c;
            const int par = c & 1;
            LAS float* acum = (LAS float*)(lds + ACUM_OFF + par * 512 + hd * 256);
            LAS float* dtv = (LAS float*)(lds + DTV_OFF + par * 512 + hd * 256);
            if (wv == 0) {
                const float xr = bf_lo(rawdt) + dtbias;
                const float dtval = fmaxf(xr, 0.f) + __logf(1.0f + __expf(-fabsf(xr)));
                float a = dtval * Acoef;
                a += __builtin_bit_cast(float, __builtin_amdgcn_update_dpp(0, __builtin_bit_cast(int, a), 0x111, 0xf, 0xf, false));
                a += __builtin_bit_cast(float, __builtin_amdgcn_update_dpp(0, __builtin_bit_cast(int, a), 0x112, 0xf, 0xf, false));
                a += __builtin_bit_cast(float, __builtin_amdgcn_update_dpp(0, __builtin_bit_cast(int, a), 0x114, 0xf, 0xf, false));
                a += __builtin_bit_cast(float, __builtin_amdgcn_update_dpp(0, __builtin_bit_cast(int, a), 0x118, 0xf, 0xf, false));
                a += __builtin_bit_cast(float, __builtin_amdgcn_update_dpp(0, __builtin_bit_cast(int, a), 0x142, 0xa, 0xf, false));
                a += __builtin_bit_cast(float, __builtin_amdgcn_update_dpp(0, __builtin_bit_cast(int, a), 0x143, 0xc, 0xf, false));
                acum[lane] = a; dtv[lane] = dtval;
            }
            __syncthreads();
            {
                const int xh = cg >> 3;
                LAS float* ac2 = (LAS float*)(lds + ACUM_OFF + par * 512 + xh * 256); LAS float* dt2 = (LAS float*)(lds + DTV_OFF + par * 512 + xh * 256);
                const float alast = ac2[63];
#pragma unroll
                for (int j = 0; j < 6; ++j) {
                    const int i = lrow + 32 * (j & 1);
                    const int aoff = (j < 2 ? XS_OFF : (j < 4 ? BS_OFF : CS_OFF)) + cg * 16 + rowaddr(i);
                    *(LAS u32x4*)(lds + aoff) = raw[j];
                    if (j < 2) {
                        const float wgt = __expf(alast - ac2[i]) * dt2[i];
                        float val[8]; unpack8(raw[j], val);
#pragma unroll
                        for (int e = 0; e < 8; ++e) val[e] *= wgt;
                        *(LAS u32x4*)(lds + (XWS_OFF - XS_OFF) + aoff) = pack8(val);
                    }
                }
            }
            if (c + 1 < SEQ / 64) load_chunk(c + 1);
            __syncthreads();
            for (int ti = wid; ti < 10; ti += 8) {
                const int it = ti < 1 ? 0 : (ti < 3 ? 1 : (ti < 6 ? 2 : 3)), jt = ti - (it * (it + 1)) / 2;
                f32x4 cacc = (f32x4){0.f, 0.f, 0.f, 0.f};
#pragma unroll
                for (int kk = 0; kk < 4; ++kk) {
                    const bf16x8 a = lds_b128(lds + BS_OFF + rowaddr(jt * 16 + fr) + (kk * 32 + fq * 8) * 2);
                    const bf16x8 bb = lds_b128(lds + CS_OFF + rowaddr(it * 16 + fr) + (kk * 32 + fq * 8) * 2);
                    cacc = MFMA16(a, bb, cacc);
                }
                const int i = it * 16 + fr, j0 = jt * 16 + fq * 4;
#pragma unroll
                for (int hh = 0; hh < 2; ++hh) {
                    LAS float* ac = (LAS float*)(lds + ACUM_OFF + par * 512 + hh * 256); LAS float* dv = (LAS float*)(lds + DTV_OFF + par * 512 + hh * 256);
                    const float ai = ac[i];
                    const f32x4 aj = *(LAS f32x4*)(ac + j0), dj = *(LAS f32x4*)(dv + j0);
                    float m[4];
#pragma unroll
                    for (int e = 0; e < 4; ++e) m[e] = (j0 + e <= i) ? cacc[e] * __expf(ai - aj[e]) * dj[e] : 0.f;
                    u32x2 o; o[0] = cvt_pk_bf16(m[0], m[1]); o[1] = cvt_pk_bf16(m[2], m[3]);
                    *(LAS u32x2*)(lds + MT_OFF + hh * HDS + i * JLD + j0 * 2) = o;
                }
            }
            f32x4 yint[4], yacc[4];
#pragma unroll
            for (int it = 0; it < 4; ++it) { yint[it] = (f32x4){0.f, 0.f, 0.f, 0.f}; yacc[it] = yint[it]; }
#pragma unroll
            for (int pp = 0; pp < 4; ++pp) {
                const bf16x8 sa = pack_acc2(accS[2 * pp], accS[2 * pp + 1]);
#pragma unroll
                for (int it = 0; it < 4; ++it) {
                    LAS unsigned char* cp = lds + CS_OFF + rowaddr(it * 16 + fr) + (pp * 32 + fq * 4) * 2;
                    yint[it] = MFMA16(sa, lds_2xb64(cp, cp + 32), yint[it]);
                }
            }
            __syncthreads();
            {
                const int pt = wv, pc0 = hd * 64 + pt * 16;
                const bf16x8 xa0 = lds_tr_frag(lds + XS_OFF, 0, pc0, lane), xa1 = lds_tr_frag(lds + XS_OFF, 32, pc0, lane);
#pragma unroll
                for (int it = 0; it < 4; ++it) {
                    yacc[it] = MFMA16(xa0, lds_b128(lds + MT_OFF + hd * HDS + (it * 16 + fr) * JLD + fq * 16), yacc[it]);
                    if (it >= 2) yacc[it] = MFMA16(xa1, lds_b128(lds + MT_OFF + hd * HDS + (it * 16 + fr) * JLD + (32 + fq * 8) * 2), yacc[it]);
                    const int i = it * 16 + fr; const float ei = __expf(acum[i]);
                    const int tt = dir ? 63 - i : i;
                    u32x2 o; o[0] = cvt_pk_bf16(yacc[it][0] + ei * yint[it][0], yacc[it][1] + ei * yint[it][1]); o[1] = cvt_pk_bf16(yacc[it][2] + ei * yint[it][2], yacc[it][3] + ei * yint[it][3]);
                    *(u32x2*)(yb + (size_t)(b * SEQ + t0 + tt) * DM + head * 64 + pt * 16 + fq * 4) = o;
                }
                const float sc = __expf(acum[63]);
                const bf16x8 xw0 = lds_tr_frag(lds + XWS_OFF, 0, pc0, lane), xw1 = lds_tr_frag(lds + XWS_OFF, 32, pc0, lane);
#pragma unroll
                for (int nt = 0; nt < 8; ++nt) {
                    accS[nt] = accS[nt] * sc;
                    accS[nt] = MFMA16(lds_tr_frag(lds + BS_OFF, 0, nt * 16, lane), xw0, accS[nt]);
                    accS[nt] = MFMA16(lds_tr_frag(lds + BS_OFF, 32, nt * 16, lane), xw1, accS[nt]);
                }
            }
        }
        __syncthreads();
    }
}

__device__ __forceinline__ void post_d_phase(const int wbase, const Params& p) {
    const bf16_t* yf = (const bf16_t*)(p.ws + WS_YF); const bf16_t* yb = (const bf16_t*)(p.ws + WS_YB); const bf16_t* xact = (const bf16_t*)(p.ws + WS_XACT);
    bf16_t* mix = (bf16_t*)p.out;
    const int tid_ = opaque_tid(wbase); const int lane = tid_ & 63, wv = blockIdx.x * 8 + (tid_ >> 6), nwv = gridDim.x * 8;
    float nw[4][8], dskv[4];
#pragma unroll
    for (int i = 0; i < 4; ++i) {
        const int c8 = (i * 64 + lane) * 8;
        const f32x4 w0 = *(const f32x4*)(p.ssd_norm_w + c8), w1 = *(const f32x4*)(p.ssd_norm_w + c8 + 4);
#pragma unroll
        for (int e = 0; e < 8; ++e) nw[i][e] = e < 4 ? w0[e & 3] : w1[e & 3];
        dskv[i] = p.ssd_d[c8 >> 6];
    }
#pragma unroll 1
    for (int tok = wv; tok < TOK; tok += nwv) {
        float y[4][8]; float ss = 0.f;
#pragma unroll
        for (int i = 0; i < 4; ++i) {
            const int c8 = (i * 64 + lane) * 8;
            float a[8], bb[8], z[8], s[8];
            unpack8(*(const u32x4*)(yf + (size_t)tok * DM + c8), a); unpack8(*(const u32x4*)(yb + (size_t)tok * DM + c8), bb);
            unpack8(*(const u32x4*)(mix + (size_t)tok * 4096 + 2048 + c8), z);
            unpack8(*(const u32x4*)(xact + (size_t)tok * DM + c8), s);
            const float dsk = dskv[i];
#pragma unroll
            for (int e = 0; e < 8; ++e) { const float v = (a[e] + bb[e] + s[e] * dsk) * silu_f(z[e]); y[i][e] = v; ss += v * v; }
            __builtin_amdgcn_sched_barrier(0);
        }
#pragma unroll
        for (int s = 32; s >= 1; s >>= 1) ss += __shfl_xor(ss, s);
        const float rs = rsqrtf(ss * (1.0f / DM) + EPS);
#pragma unroll
        for (int i = 0; i < 4; ++i) {
            const int c8 = (i * 64 + lane) * 8;
            float o[8];
#pragma unroll
            for (int e = 0; e < 8; ++e) o[e] = y[i][e] * rs * nw[i][e];
            *(u32x4*)(mix + (size_t)tok * 4096 + 2048 + c8) = pack8(o);
        }
    }
}


#define XB_TMO      128
#define XB_XCNT(j)  (256  + 64 * (j))
#define XB_XSUB(j)  (1280 + 64 * (j))
#define XB_XGEN(j)  (2304 + 64 * (j))
#define XB_TOP      3328
#define XB_TOPGEN   3392
#define XCD_BAR_WORDS 3456
#define XB_SPIN_CAP (1u << 18)
constexpr size_t WS_BAR = 504 * MiB;
__device__ __forceinline__ unsigned xb_ld(unsigned* p)              { return __hip_atomic_load(p, __ATOMIC_RELAXED, __HIP_MEMORY_SCOPE_AGENT); }
__device__ __forceinline__ unsigned xb_add(unsigned* p, unsigned v) { return __hip_atomic_fetch_add(p, v, __ATOMIC_RELAXED, __HIP_MEMORY_SCOPE_AGENT); }
__device__ __forceinline__ unsigned xb_xcc_id() { return (unsigned)__builtin_amdgcn_s_getreg((3 << 11) | 20) & 0xFu; }
#define XB_SPIN(cond, bar) do { unsigned _sp = 0; while (cond) { __builtin_amdgcn_s_sleep(1); \
    if ((++_sp & 255u) == 0u) { if (xb_ld(&(bar)[XB_TMO])) break; if (_sp > XB_SPIN_CAP) { atomicAdd(&(bar)[XB_TMO], 1u); break; } } } } while (0)
struct XcdBarrier { unsigned* bar; unsigned x; volatile LAS unsigned* st; };
__device__ __forceinline__ XcdBarrier xcd_barrier_post(unsigned* bar, volatile LAS unsigned* st) {
    XcdBarrier b; b.bar = bar; b.x = xb_xcc_id(); b.st = st;
    if (threadIdx.x == 0) (void)xb_add(&bar[XB_XCNT(b.x)], 1u);
    return b;
}
__device__ __forceinline__ void xcd_barrier_complete(unsigned* bar, unsigned x, unsigned& nloc, unsigned& nx) {
    const unsigned G = gridDim.x * gridDim.y * gridDim.z;
    unsigned sum, cnt, mine, sp = 0u;
    for (;;) {
        sum = 0u; cnt = 0u; mine = 0u;
#pragma unroll
        for (unsigned j = 0; j < 16; ++j) { const unsigned c = xb_ld(&bar[XB_XCNT(j)]); sum += c; cnt += (c > 0u) ? 1u : 0u; mine = (j == x) ? c : mine; }
        if (sum == G) break;
        __builtin_amdgcn_s_sleep(1);
        if ((++sp & 255u) == 0u) { if (xb_ld(&bar[XB_TMO])) break; if (sp > XB_SPIN_CAP) { atomicAdd(&bar[XB_TMO], 1u); break; } }
    }
    nloc = mine > 0u ? mine : 1u; nx = cnt > 0u ? cnt : 1u;
}
__device__ __forceinline__ void xcd_barrier(const int wbase, const XcdBarrier& b) {
    asm volatile("s_waitcnt vmcnt(0)" ::: "memory");
    __syncthreads();
    if (opaque_tid(wbase) == 0) {
        unsigned* bar = b.bar;
        __builtin_amdgcn_s_waitcnt(0);
        unsigned nloc = b.st[0], nx = b.st[1];
        if (nloc == 0u) { xcd_barrier_complete(bar, b.x, nloc, nx); b.st[0] = nloc; b.st[1] = nx; }
        const unsigned old = xb_add(&bar[XB_XSUB(b.x)], 1u);
        const unsigned gen = old / nloc;
        if (old + 1u == (gen + 1u) * nloc) {
            __builtin_amdgcn_fence(__ATOMIC_RELEASE, "agent");
            asm volatile("s_waitcnt vmcnt(0)" ::: "memory");
            const unsigned og = xb_add(&bar[XB_TOP], 1u);
            const unsigned tg = og / nx;
            if (og + 1u == (tg + 1u) * nx) xb_add(&bar[XB_TOPGEN], 1u);
            else XB_SPIN(xb_ld(&bar[XB_TOPGEN]) == tg, bar);
            __builtin_amdgcn_fence(__ATOMIC_ACQUIRE, "agent");
            xb_add(&bar[XB_XGEN(b.x)], 1u);
            asm volatile("s_waitcnt vmcnt(0)" ::: "memory");
        } else {
            XB_SPIN(xb_ld(&bar[XB_XGEN(b.x)]) == gen, bar);
            __builtin_amdgcn_fence(__ATOMIC_ACQUIRE, "agent");
            asm volatile("s_waitcnt vmcnt(0)" ::: "memory");
        }
    }
    __syncthreads();
}

constexpr int NPHASE = 18;
__global__ void __launch_bounds__(512, 2) fwd_megakernel(Params p) {
    extern __shared__ __attribute__((aligned(16))) unsigned char shm[];
    LAS unsigned char* lds = (LAS unsigned char*)shm;
    cg::grid_group grid = cg::this_grid();
    const int wbase = __builtin_amdgcn_readfirstlane((int)(threadIdx.x >> 6)) * 64;
    if (threadIdx.x == 0) { ((volatile LAS unsigned*)(lds + 131072))[0] = 0u; ((volatile LAS unsigned*)(lds + 131072))[1] = 0u; }
    __syncthreads();
    XcdBarrier bar = xcd_barrier_post((unsigned*)(p.ws + WS_BAR), (volatile LAS unsigned*)(lds + 131072));
    if (p.ph_lo < 0) grid.sync();
    unsigned char* ws = p.ws;
    bf16_t* mix = (bf16_t*)p.out;
#define PH_BEGIN(k) if (p.ph_lo <= (k) && (k) < p.ph_hi) { if ((k) > p.ph_lo) xcd_barrier(wbase, bar);
#define PH_GEMM(k) PH_BEGIN(k) GemmJob g; \
        g.A = nullptr; g.Bt = nullptr; g.lda = g.ldb = 2048; g.nM = g.nN = 1; g.K = 2048; g.mode = MODE_SEG; \
        g.strideAz = 0; g.strideBz = 0; g.strideBpm = 0; g.Z = 1; g.c0 = g.c1 = g.c2 = g.c3 = g.c4 = nullptr; g.ld0 = g.ld1 = g.ld2 = g.ld3 = g.ld4 = 2048; \
        g.t1 = g.t2 = g.t3 = g.t4 = 1 << 20; g.fbias = nullptr; g.resid = nullptr; g.outf = nullptr;
#define PH_END }
    PH_BEGIN(0)
        transpose_cvt(wbase, lds, p.ev_w_in, 2048, 14336, (bf16_t*)(ws + WS_WIN));
        transpose_cvt(wbase, lds, p.ev_w_out, 4096, 2048, (bf16_t*)(ws + WS_WOUT));
        build_dft(wbase, (bf16_t*)(ws + WS_DFT));
        build_w12(wbase, lds, p.fnet_w, (bf16_t*)(ws + WS_W12));
        rmsnorm_to_bf16(wbase, p.x, p.norm_w, (bf16_t*)(ws + WS_H));
    PH_END
    PH_GEMM(1)
        g.A = (const char*)(ws + WS_H); g.Bt = (const char*)(ws + WS_WIN) + (size_t)10240 * 2048 * 2; g.lda = 2048; g.ldb = 2048; g.nM = 64; g.nN = 16; g.K = 2048; g.mode = MODE_SEG;
        g.c0 = (bf16_t*)(ws + WS_S0); g.ld0 = 2048; g.c1 = mix + 2048; g.ld1 = 4096; g.t1 = 8;
        gemm_phase(wbase, lds, g);
    PH_END
    PH_BEGIN(2) fold_phase(wbase, p); PH_END
    PH_GEMM(3)
        g.A = (const char*)(ws + WS_W12); g.strideAz = (size_t)512 * 256 * 2; g.lda = 256; g.Bt = (const char*)(ws + WS_UF); g.strideBz = 256 * 2; g.ldb = 2048; g.strideBpm = (size_t)8192 * 2048 * 2;
        g.nM = 2; g.nN = 32; g.Z = 8; g.K = 256; g.mode = MODE_PT; g.c0 = (bf16_t*)(ws + WS_S2);
        gemm_phase(wbase, lds, g);
    PH_END
    PH_GEMM(4)
        g.A = (const char*)(ws + WS_DFT); g.lda = 2048; g.Bt = (const char*)(ws + WS_S2); g.strideBz = (size_t)2048 * 2048 * 2; g.ldb = 2048;
        g.nM = 8; g.nN = 8; g.Z = 8; g.K = 2048; g.mode = MODE_DFT; g.c0 = mix; g.fbias = p.fnet_b; g.resid = (const float*)(ws + WS_P1024);
        gemm_phase(wbase, lds, g);
    PH_END
    PH_GEMM(5)
        g.A = (const char*)(ws + WS_H); g.Bt = (const char*)(ws + WS_WIN); g.lda = 2048; g.ldb = 2048; g.nM = 64; g.nN = 40; g.K = 2048; g.mode = MODE_SEG;
        g.c0 = (bf16_t*)(ws + WS_S0); g.c1 = (bf16_t*)(ws + WS_S1); g.t1 = 8; g.c2 = (bf16_t*)(ws + WS_S2); g.t2 = 16; g.c3 = (bf16_t*)(ws + WS_S3); g.t3 = 24; g.c4 = mix; g.ld4 = 4096; g.t4 = 32;
        gemm_phase(wbase, lds, g);
    PH_END
    PH_BEGIN(6) gla_phase(wbase, lds, p); PH_END
    PH_BEGIN(7) post_a_phase(wbase, p); PH_END
    PH_GEMM(8)
        g.A = (const char*)mix; g.lda = 4096; g.Bt = (const char*)(ws + WS_WOUT); g.ldb = 4096; g.nM = 64; g.nN = 8; g.K = 4096; g.mode = MODE_RES0;
        g.resid = p.x; g.c0 = (bf16_t*)(ws + WS_X1);
        gemm_phase(wbase, lds, g);
    PH_END
    PH_BEGIN(9)
        transpose_cvt<true>(wbase, lds, p.od_w_in, 2048, 13376, (bf16_t*)(ws + WS_WIN));
        zero_fill16(wbase, ws + WS_WIN + (size_t)13376 * 2048 * 2, (size_t)192 * 2048 * 2);
        transpose_cvt(wbase, lds, p.od_w_out, 4096, 2048, (bf16_t*)(ws + WS_WOUT));
        rmsnorm_from_bf16<false>(wbase, (const bf16_t*)(ws + WS_X1), p.norm_w + 2048, (void*)(ws + WS_H1));
    PH_END
    PH_GEMM(10)
        g.A = (const char*)(ws + WS_H1); g.Bt = (const char*)(ws + WS_WIN); g.lda = 2048; g.ldb = 2048; g.nM = 64; g.nN = 32; g.K = 2048; g.mode = MODE_PAIR;
        g.c0 = (bf16_t*)(ws + WS_CIN); g.c1 = mix;
        gemm_phase(wbase, lds, g);
    PH_END
    PH_BEGIN(11) conv_c_phase(wbase, p); PH_END
    PH_GEMM(12)
        g.A = (const char*)(ws + WS_H1); g.Bt = (const char*)(ws + WS_WIN) + (size_t)8192 * 2048 * 2; g.lda = 2048; g.ldb = 2048; g.nM = 64; g.nN = 21; g.K = 2048; g.mode = MODE_SEG;
        g.c0 = mix + 2048; g.ld0 = 4096; g.c1 = (bf16_t*)(ws + WS_XBC); g.ld1 = 3072; g.t1 = 8; g.c2 = (bf16_t*)(ws + WS_DT); g.ld2 = 256; g.t2 = 20;
        gemm_phase(wbase, lds, g);
    PH_END
    PH_BEGIN(13) preconv_phase(wbase, p); PH_END
    PH_BEGIN(14) ssd_phase(wbase, lds, p); PH_END
    PH_BEGIN(15) post_d_phase(wbase, p); PH_END
    PH_GEMM(16)
        g.A = (const char*)mix; g.lda = 4096; g.Bt = (const char*)(ws + WS_WOUT); g.ldb = 4096; g.nM = 64; g.nN = 8; g.K = 4096; g.mode = MODE_RES1;
        g.c0 = (bf16_t*)(ws + WS_X1);
        gemm_phase(wbase, lds, g);
    PH_END
    PH_BEGIN(17) rmsnorm_from_bf16<true>(wbase, (const bf16_t*)(ws + WS_X1), p.final_norm_w, (void*)p.out); PH_END
}


extern "C" void kernel_launch(void* const* d_in, const int* in_sizes, int n_in, void* d_out, int out_size, void* d_ws, size_t ws_size, hipStream_t stream) {
    static int grid_blocks = 0;
    if (!grid_blocks) {
        int dev = 0, cus = 0, per_cu = 0;
        hipGetDevice(&dev);
        hipDeviceGetAttribute(&cus, hipDeviceAttributeMultiprocessorCount, dev);
        hipFuncSetAttribute((const void*)fwd_megakernel, hipFuncAttributeMaxDynamicSharedMemorySize, LDS_BYTES);
        hipOccupancyMaxActiveBlocksPerMultiprocessor(&per_cu, (const void*)fwd_megakernel, 512, LDS_BYTES);
        if (per_cu < 1) per_cu = 1;
        grid_blocks = cus * per_cu;
        if (grid_blocks > 256) grid_blocks = 256;
        (void)hipGetLastError();
    }
    Params p{};
    p.x = (const float*)d_in[0]; p.norm_w = (const float*)d_in[1]; p.final_norm_w = (const float*)d_in[2]; p.ev_w_in = (const float*)d_in[3]; p.ev_w_out = (const float*)d_in[4];
    p.lb_logits = (const float*)d_in[5]; p.hgrn_norm_w = (const float*)d_in[6]; p.fnet_w = (const float*)d_in[7]; p.fnet_b = (const float*)d_in[8];
    p.od_w_in = (const float*)d_in[9]; p.od_w_out = (const float*)d_in[10]; p.sconv_w = (const float*)d_in[11]; p.ssd_conv_w = (const float*)d_in[12]; p.ssd_conv_b = (const float*)d_in[13];
    p.dt_bias = (const float*)d_in[14]; p.a_log = (const float*)d_in[15]; p.ssd_d = (const float*)d_in[16]; p.ssd_norm_w = (const float*)d_in[17];
    p.out = (float*)d_out; p.ws = (unsigned char*)d_ws; p.ph_lo = 0; p.ph_hi = NPHASE;
    (void)hipMemsetAsync((unsigned char*)d_ws + WS_BAR, 0, XCD_BAR_WORDS * 4, stream);
    void* args[] = {&p};
    hipError_t e = hipLaunchCooperativeKernel((const void*)fwd_megakernel, dim3(grid_blocks), dim3(512), args, LDS_BYTES, stream);
    if (e != hipSuccess) fprintf(stderr, "cooperative launch failed: %s (grid %d)\n", hipGetErrorString(e), grid_blocks);
}
```

```cpp
#include <hip/hip_runtime.h>
#include <hip/hip_cooperative_groups.h>
#include <cstdio>
namespace cg = cooperative_groups;

#define LAS __attribute__((address_space(3)))
typedef unsigned short bf16_t;
typedef short bf16x8 __attribute__((ext_vector_type(8)));
typedef float f32x4 __attribute__((ext_vector_type(4)));
typedef float f32x2 __attribute__((ext_vector_type(2)));
typedef unsigned u32x4 __attribute__((ext_vector_type(4)));
typedef unsigned u32x2 __attribute__((ext_vector_type(2)));

constexpr int TOK = 16384, DM = 2048, SEQ = 2048;
constexpr size_t MiB = 1ull << 20;
constexpr size_t WS_WIN = 0, WS_WOUT = 56 * MiB, WS_S0 = 72 * MiB, WS_S1 = 136 * MiB, WS_S2 = 200 * MiB, WS_S3 = 264 * MiB,
                 WS_DFT = 328 * MiB, WS_W12 = 344 * MiB, WS_P1024 = 346 * MiB, WS_H = 348 * MiB, WS_UF = 412 * MiB;
constexpr size_t WS_X1 = WS_S0, WS_H1 = 200 * MiB, WS_CIN = 264 * MiB, WS_CB = 328 * MiB, WS_CC = 392 * MiB,
                 WS_XBC = 264 * MiB, WS_DT = 360 * MiB, WS_YF = 368 * MiB, WS_YB = 432 * MiB,
                 WS_XACT = 200 * MiB  , WS_BCACT = 0  ;
constexpr int LDS_BYTES = 131072 + 16;
constexpr float EPS = 1e-6f;

struct Params {
    const float* x; const float* norm_w; const float* final_norm_w; const float* ev_w_in; const float* ev_w_out;
    const float* lb_logits; const float* hgrn_norm_w; const float* fnet_w; const float* fnet_b;
    const float* od_w_in; const float* od_w_out; const float* sconv_w; const float* ssd_conv_w; const float* ssd_conv_b;
    const float* dt_bias; const float* a_log; const float* ssd_d; const float* ssd_norm_w;
    float* out; unsigned char* ws;
    int ph_lo, ph_hi;
};

typedef __bf16 bf16x2_t __attribute__((ext_vector_type(2)));
__device__ __forceinline__ unsigned cvt_pk_bf16(float lo, float hi) {
    f32x2 v = {lo, hi}; union { bf16x2_t b; unsigned u; } c; c.b = __builtin_convertvector(v, bf16x2_t); return c.u; }
__device__ __forceinline__ float bf_lo(unsigned w) { return __uint_as_float(w << 16); }
__device__ __forceinline__ float bf_hi(unsigned w) { return __uint_as_float(w & 0xffff0000u); }
__device__ __forceinline__ void unpack8(const u32x4 v, float* f) {
    f[0] = bf_lo(v[0]); f[1] = bf_hi(v[0]); f[2] = bf_lo(v[1]); f[3] = bf_hi(v[1]);
    f[4] = bf_lo(v[2]); f[5] = bf_hi(v[2]); f[6] = bf_lo(v[3]); f[7] = bf_hi(v[3]);
}
__device__ __forceinline__ u32x4 pack8(const float* f) {
    u32x4 r; r[0] = cvt_pk_bf16(f[0], f[1]); r[1] = cvt_pk_bf16(f[2], f[3]); r[2] = cvt_pk_bf16(f[4], f[5]); r[3] = cvt_pk_bf16(f[6], f[7]); return r;
}
__device__ __forceinline__ float silu_f(float x) { return x * __builtin_amdgcn_rcpf(1.0f + __expf(-x)); }
__device__ __forceinline__ bf16x8 as_bf16x8(u32x4 v) { union { u32x4 u; bf16x8 b; } c; c.u = v; return c.b; }
__device__ __forceinline__ bf16x8 lds_b128(LAS unsigned char* p) { return *(LAS bf16x8*)p; }
__device__ __forceinline__ bf16x8 lds_2xb64(LAS unsigned char* p0, LAS unsigned char* p1) {
    u32x2 a = *(LAS u32x2*)p0, b = *(LAS u32x2*)p1; u32x4 v; v[0] = a[0]; v[1] = a[1]; v[2] = b[0]; v[3] = b[1]; return as_bf16x8(v);
}
__device__ __forceinline__ bf16x8 pack_acc2(const f32x4 a, const f32x4 b) {
    u32x4 v; v[0] = cvt_pk_bf16(a[0], a[1]); v[1] = cvt_pk_bf16(a[2], a[3]); v[2] = cvt_pk_bf16(b[0], b[1]); v[3] = cvt_pk_bf16(b[2], b[3]); return as_bf16x8(v);
}
__device__ __forceinline__ int opaque_tid(const int wbase) { int t = wbase + (int)__builtin_amdgcn_mbcnt_hi(~0u, __builtin_amdgcn_mbcnt_lo(~0u, 0u)); asm volatile("" : "+v"(t)); return t; }
typedef short s16x4 __attribute__((ext_vector_type(4)));
constexpr int PN = 288;
__device__ __forceinline__ int rowaddr(int r) { return r * PN + ((r >> 3) & 7) * 16; }
__device__ __forceinline__ bf16x8 lds_tr_frag(LAS unsigned char* base, int r0, int c0, int lane) {
    const int g = lane >> 4, q = (lane & 15) >> 2, pp = lane & 3;
    LAS unsigned char* a0 = base + rowaddr(r0 + 8 * g + q) + c0 * 2 + 8 * pp;
    const s16x4 lo = __builtin_amdgcn_ds_read_tr16_b64_v4i16((LAS s16x4*)a0);
    const s16x4 hi = __builtin_amdgcn_ds_read_tr16_b64_v4i16((LAS s16x4*)(a0 + 4 * PN));
    bf16x8 r; r[0] = lo[0]; r[1] = lo[1]; r[2] = lo[2]; r[3] = lo[3]; r[4] = hi[0]; r[5] = hi[1]; r[6] = hi[2]; r[7] = hi[3]; return r;
}
#define MFMA16(a, b, c) __builtin_amdgcn_mfma_f32_16x16x32_bf16((a), (b), (c), 0, 0, 0)

constexpr int BM = 256, BK = 64, HALF = 128, HTB = HALF * BK * 2, NXCD = 8, WGM = 4;
__device__ __forceinline__ int lds_byte(int r, int c) { const int st = (r >> 4) * 2 + (c >> 5), rr = r & 15, cc = c & 31, ob = rr * 64 + cc * 2; return st * 1024 + (ob ^ (((ob >> 9) & 1) << 5)); }
__device__ __forceinline__ void stage_rc(int b, int& R, int& C) { const int st = b / 1024, sb = b % 1024, swz = sb ^ (((sb >> 9) & 1) << 5); R = (st >> 1) * 16 + swz / 64; C = (st & 1) * 32 + (swz % 64) / 2; }
__device__ __forceinline__ int perm32(int rho) { const int n = rho >> 4, i = rho & 15; return 8 * (i >> 2) + 4 * n + (i & 3); }

__device__ __forceinline__ bf16_t* rfl_ptr(bf16_t* p) { const unsigned long long v = (unsigned long long)p; const unsigned lo = __builtin_amdgcn_readfirstlane((unsigned)v), hi = __builtin_amdgcn_readfirstlane((unsigned)(v >> 32)); return (bf16_t*)(((unsigned long long)hi << 32) | lo); }
enum { MODE_SEG = 0, MODE_PT = 1, MODE_DFT = 2, MODE_RES0 = 3, MODE_RES1 = 4, MODE_PAIR = 5 };
struct GemmJob {
    const char* A; const char* Bt; size_t strideAz, strideBz, strideBpm;
    int lda, ldb, nM, nN, Z, K, mode;
    bf16_t* c0; bf16_t* c1; bf16_t* c2; bf16_t* c3; bf16_t* c4;
    int ld0, ld1, ld2, ld3, ld4, t1, t2, t3, t4;
    const float* fbias; const float* resid; float* outf;
};
struct Unit { int z, pm, pn; };

__device__ __forceinline__ bool next_unit(const GemmJob& g, int i, Unit& u) {
    const int nwg = g.nM * g.nN;
    const long L = (long)i * gridDim.x + blockIdx.x;
    if (L >= (long)g.Z * nwg) return false;
    const int z = (int)(L / nwg); int wgid = (int)(L - (long)z * nwg);
    { const int q = nwg / NXCD, r = nwg % NXCD, xcd = wgid % NXCD, off = wgid / NXCD; wgid = (xcd < r ? xcd * (q + 1) : r * (q + 1) + (xcd - r) * q) + off; }
    const int nig = WGM * g.nN, gid = wgid / nig, fm = gid * WGM, gsz = (g.nM - fm) < WGM ? (g.nM - fm) : WGM;
    u.pm = fm + ((wgid % nig) % gsz); u.pn = (wgid % nig) / gsz; u.z = z; return true;
}

__device__ __forceinline__ void gemm_epilogue(const f32x4 (&acc)[2][2][4][2], const GemmJob& g, const Unit& u, int wr, int wc, int fr, int fq) {
    const int rloc = wr * 64 + fr, cloc = wc * 32 + 8 * fq;
    if (g.mode == MODE_SEG || g.mode == MODE_PT) {
        bf16_t* base; int ld;
        if (g.mode == MODE_SEG) {
            bf16_t* s0 = g.c0; bf16_t* s1 = g.c1; bf16_t* s2 = g.c2; bf16_t* s3 = g.c3; bf16_t* s4 = g.c4;
            int e0 = g.ld0, e1 = g.ld1, e2 = g.ld2, e3 = g.ld3, e4 = g.ld4, f1 = g.t1, f2 = g.t2, f3 = g.t3, f4 = g.t4;
            s0 = rfl_ptr(s0); s1 = rfl_ptr(s1); s2 = rfl_ptr(s2); s3 = rfl_ptr(s3); s4 = rfl_ptr(s4);
            e0 = __builtin_amdgcn_readfirstlane(e0); e1 = __builtin_amdgcn_readfirstlane(e1); e2 = __builtin_amdgcn_readfirstlane(e2); e3 = __builtin_amdgcn_readfirstlane(e3); e4 = __builtin_amdgcn_readfirstlane(e4);
            f1 = __builtin_amdgcn_readfirstlane(f1); f2 = __builtin_amdgcn_readfirstlane(f2); f3 = __builtin_amdgcn_readfirstlane(f3); f4 = __builtin_amdgcn_readfirstlane(f4);
            base = s0; ld = e0; int t0 = 0;
            if (u.pn >= f1) { base = s1; ld = e1; t0 = f1; }
            if (u.pn >= f2) { base = s2; ld = e2; t0 = f2; }
            if (u.pn >= f3) { base = s3; ld = e3; t0 = f3; }
            if (u.pn >= f4) { base = s4; ld = e4; t0 = f4; }
            base += (size_t)(u.pm * BM) * ld + (size_t)(u.pn - t0) * BM;
        } else {
            const int b = u.pn >> 2, l0 = (u.pn & 3) * 256; ld = 2048;
            base = g.c0 + ((size_t)(b * 2048 + u.z * 256)) * 2048 + (size_t)u.pm * 1024 + l0;
        }
#pragma unroll
        for (int ai = 0; ai < 2; ++ai)
#pragma unroll
            for (int m = 0; m < 4; ++m) {
                bf16_t* rowp = base + (size_t)(rloc + ai * HALF + m * 16) * ld + cloc;
#pragma unroll
                for (int bj = 0; bj < 2; ++bj) {
                    const f32x4 v0 = acc[ai][bj][m][0], v1 = acc[ai][bj][m][1];
                    u32x4 o; o[0] = cvt_pk_bf16(v0[0], v0[1]); o[1] = cvt_pk_bf16(v0[2], v0[3]); o[2] = cvt_pk_bf16(v1[0], v1[1]); o[3] = cvt_pk_bf16(v1[2], v1[3]);
                    *(u32x4*)(rowp + bj * HALF) = o;
                }
            }
    } else if (g.mode == MODE_PAIR) {
        const bool second = u.pn >= 16;
        bf16_t* base = second ? g.c1 : g.c0; const int ld = second ? 4096 : 2048;
        base += (size_t)(u.pm * BM) * ld + (size_t)(u.pn & 15) * 128 + cloc;
#pragma unroll
        for (int ai = 0; ai < 2; ++ai)
#pragma unroll
            for (int m = 0; m < 4; ++m) {
                float r[8];
#pragma unroll
                for (int e = 0; e < 4; ++e) {
                    const float a0 = acc[ai][0][m][0][e], a1 = acc[ai][0][m][1][e], p0 = acc[ai][1][m][0][e], p1 = acc[ai][1][m][1][e];
                    r[e] = second ? a0 * silu_f(p0) : a0 * p0; r[4 + e] = second ? a1 * silu_f(p1) : a1 * p1;
                }
                *(u32x4*)(base + (size_t)(rloc + ai * HALF + m * 16) * ld) = pack8(r);
            }
    } else if (g.mode == MODE_DFT) {
        const int col0 = u.pn * BM + cloc;
        const float sgn = (fr & 1) ? -1.0f : 1.0f;
#pragma unroll
        for (int bj = 0; bj < 2; ++bj) {
            const f32x4 q0 = *(const f32x4*)(g.resid + u.z * 2048 + col0 + bj * HALF), q1 = *(const f32x4*)(g.resid + u.z * 2048 + col0 + bj * HALF + 4);
            const f32x4 b0 = *(const f32x4*)(g.fbias + col0 + bj * HALF) + q0 * sgn, b1 = *(const f32x4*)(g.fbias + col0 + bj * HALF + 4) + q1 * sgn;
            bf16_t* pp0 = g.c0 + (size_t)(u.z * 2048 + u.pm * BM + rloc) * 4096 + 2048 + col0 + bj * HALF;
            u32x4 gt[2][4];
#pragma unroll
            for (int ai = 0; ai < 2; ++ai)
#pragma unroll
                for (int m = 0; m < 4; ++m) gt[ai][m] = *(const u32x4*)(pp0 + (size_t)(ai * HALF + m * 16) * 4096);
#pragma unroll
            for (int ai = 0; ai < 2; ++ai)
#pragma unroll
                for (int m = 0; m < 4; ++m) {
                    float gf[8]; unpack8(gt[ai][m], gf);
                    const f32x4 v0 = acc[ai][bj][m][0] + b0, v1 = acc[ai][bj][m][1] + b1;
                    float r[8];
#pragma unroll
                    for (int e = 0; e < 4; ++e) { r[e] = v0[e] * silu_f(gf[e]); r[4 + e] = v1[e] * silu_f(gf[4 + e]); }
                    *(u32x4*)(pp0 + (size_t)(ai * HALF + m * 16) * 4096) = pack8(r);
                }
        }
    } else {
#pragma unroll
        for (int ai = 0; ai < 2; ++ai) {
            const size_t ro0 = (size_t)(u.pm * BM + rloc + ai * HALF) * 2048 + u.pn * BM + cloc;
            float rr[4][2][8];
            if (g.mode == MODE_RES0) {
                f32x4 t0[4][2], t1[4][2];
#pragma unroll
                for (int m = 0; m < 4; ++m)
#pragma unroll
                    for (int bj = 0; bj < 2; ++bj) { t0[m][bj] = *(const f32x4*)(g.resid + ro0 + (size_t)m * 16 * 2048 + bj * HALF); t1[m][bj] = *(const f32x4*)(g.resid + ro0 + (size_t)m * 16 * 2048 + bj * HALF + 4); }
#pragma unroll
                for (int m = 0; m < 4; ++m)
#pragma unroll
                    for (int bj = 0; bj < 2; ++bj)
#pragma unroll
                        for (int e = 0; e < 4; ++e) { rr[m][bj][e] = t0[m][bj][e]; rr[m][bj][4 + e] = t1[m][bj][e]; }
            } else {
                u32x4 t[4][2];
#pragma unroll
                for (int m = 0; m < 4; ++m)
#pragma unroll
                    for (int bj = 0; bj < 2; ++bj) t[m][bj] = *(const u32x4*)(g.c0 + ro0 + (size_t)m * 16 * 2048 + bj * HALF);
#pragma unroll
                for (int m = 0; m < 4; ++m)
#pragma unroll
                    for (int bj = 0; bj < 2; ++bj) unpack8(t[m][bj], rr[m][bj]);
            }
#pragma unroll
            for (int m = 0; m < 4; ++m)
#pragma unroll
                for (int bj = 0; bj < 2; ++bj) {
#pragma unroll
                    for (int e = 0; e < 4; ++e) { rr[m][bj][e] += acc[ai][bj][m][0][e]; rr[m][bj][4 + e] += acc[ai][bj][m][1][e]; }
                    *(u32x4*)(g.c0 + ro0 + (size_t)m * 16 * 2048 + bj * HALF) = pack8(rr[m][bj]);
                }
        }
    }
}

__device__ __forceinline__ void gemm_phase(const int wbase, LAS unsigned char* lds, const GemmJob& g) {
    const int tid = opaque_tid(wbase), wid = __builtin_amdgcn_readfirstlane(tid >> 6), lane = tid & 63, wr = wid >> 2, wc = wid & 3, fr = lane & 15, fq = lane >> 4;
    const int K = g.K, nt = K / BK;
    unsigned voffA[2], voffB[2];
#pragma unroll
    for (int i = 0; i < 2; ++i) { int R, C; stage_rc(tid * 16 + i * 8192, R, C); const int Rb = (R & ~31) + perm32(R & 31);
        voffA[i] = (unsigned)(R * g.lda + C) * 2u; voffB[i] = (unsigned)(Rb * g.ldb + C) * 2u; }
    const size_t kstep = (size_t)(BK * 2);
    const size_t hstepA = (size_t)HALF * g.lda * 2, hstepB = (size_t)HALF * g.ldb * 2;
    const unsigned ldsw = (unsigned)wid * 1024u;
    const int aoff = lds_byte(wr * 64 + fr, fq * 8), boff = lds_byte(wc * 32 + fr, fq * 8);
#define PG8_SA(b, h) (((b) * 2 + (h)) * HTB)
#define PG8_SB(b, h) ((4 + (b) * 2 + (h)) * HTB)
#define PG8_STAGE(bufoff, gbase, voff) do { _Pragma("unroll") for (int _i = 0; _i < 2; ++_i) \
        __builtin_amdgcn_global_load_lds((const unsigned*)((const char*)(gbase) + (voff)[_i]), (LAS unsigned*)(lds + (bufoff) + ldsw + _i * 8192), 16, 0, 0); } while (0)
#define PG8_LDA(dst, b, h) do { _Pragma("unroll") for (int m = 0; m < 4; ++m) _Pragma("unroll") for (int k = 0; k < 2; ++k) dst[m][k] = *(const LAS bf16x8*)(lds + PG8_SA(b, h) + aoff + m * 2048 + k * 1024); } while (0)
#define PG8_LDB(dst, b, h) do { _Pragma("unroll") for (int n = 0; n < 2; ++n) _Pragma("unroll") for (int k = 0; k < 2; ++k) dst[n][k] = *(const LAS bf16x8*)(lds + PG8_SB(b, h) + boff + n * 2048 + k * 1024); } while (0)
#define PG8_MMA(ai, bj, At, Bt) do { __builtin_amdgcn_s_setprio(1); _Pragma("unroll") for (int m = 0; m < 4; ++m) _Pragma("unroll") for (int n = 0; n < 2; ++n) _Pragma("unroll") for (int k = 0; k < 2; ++k) \
        acc[ai][bj][m][n] = __builtin_amdgcn_mfma_f32_16x16x32_bf16(Bt[n][k], At[m][k], acc[ai][bj][m][n], 0, 0, 0); __builtin_amdgcn_s_setprio(0); } while (0)
#define PG8_WAIT_V(n) asm volatile("s_waitcnt vmcnt(" #n ")" ::: "memory")
#define PG8_WAIT_L(n) asm volatile("s_waitcnt lgkmcnt(" #n ")" ::: "memory")
#define PG8_BAR __builtin_amdgcn_s_barrier()
#define PG8_SCHED __builtin_amdgcn_sched_barrier(0)
    Unit cur, nxt; int ui = 0;
    if (!next_unit(g, 0, cur)) return;
    f32x4 acc[2][2][4][2];
#pragma unroll
    for (int a = 0; a < 2; ++a)
#pragma unroll
        for (int b = 0; b < 2; ++b)
#pragma unroll
            for (int m = 0; m < 4; ++m)
#pragma unroll
                for (int n = 0; n < 2; ++n) acc[a][b][m][n] = (f32x4){0.f, 0.f, 0.f, 0.f};
    bf16x8 At[4][2], B0[2][2], B1[2][2];
    const char* cA = g.A + (size_t)cur.z * g.strideAz + (size_t)cur.pm * 2 * hstepA;
    const char* cB = g.Bt + (size_t)cur.z * g.strideBz + (size_t)cur.pn * 2 * hstepB + (size_t)cur.pm * g.strideBpm;
    PG8_STAGE(PG8_SB(0, 0), cB, voffB); PG8_STAGE(PG8_SA(0, 0), cA, voffA); PG8_STAGE(PG8_SB(0, 1), cB + hstepB, voffB); PG8_STAGE(PG8_SA(0, 1), cA + hstepA, voffA);
    if (wr == 1) PG8_BAR;
    PG8_WAIT_V(4); PG8_BAR;
    PG8_STAGE(PG8_SB(1, 0), cB + kstep, voffB); PG8_STAGE(PG8_SA(1, 0), cA + kstep, voffA); PG8_STAGE(PG8_SB(1, 1), cB + hstepB + kstep, voffB);
    PG8_WAIT_V(6); PG8_BAR;
    for (;;) {
        const bool has_next = next_unit(g, ui + 1, nxt);
        const char* nA = has_next ? g.A + (size_t)nxt.z * g.strideAz + (size_t)nxt.pm * 2 * hstepA : cA;
        const char* nB = has_next ? g.Bt + (size_t)nxt.z * g.strideBz + (size_t)nxt.pn * 2 * hstepB + (size_t)nxt.pm * g.strideBpm : cB;
        for (int t = 0; t < nt; t += 2) {
            const bool last = (t == nt - 2);
            const char* a1 = cA + (size_t)(t + 1) * kstep;
            const char* a2 = last ? nA : cA + (size_t)(t + 2) * kstep; const char* b2 = last ? nB : cB + (size_t)(t + 2) * kstep;
            const char* a3 = a2 + kstep; const char* b3 = b2 + kstep;
            PG8_LDB(B0, 0, 0); PG8_SCHED; PG8_LDA(At, 0, 0); PG8_STAGE(PG8_SA(1, 1), a1 + hstepA, voffA);
            PG8_WAIT_L(8); PG8_BAR; PG8_WAIT_L(0); PG8_MMA(0, 0, At, B0); PG8_BAR; PG8_SCHED;
            PG8_LDB(B1, 0, 1); PG8_STAGE(PG8_SB(0, 0), b2, voffB);
            PG8_BAR; PG8_WAIT_L(0); PG8_MMA(0, 1, At, B1); PG8_BAR;
            PG8_LDA(At, 0, 1); PG8_STAGE(PG8_SA(0, 0), a2, voffA);
            PG8_BAR; PG8_WAIT_L(0); PG8_MMA(1, 0, At, B0); PG8_BAR; PG8_SCHED;
            PG8_STAGE(PG8_SB(0, 1), b2 + hstepB, voffB);
            PG8_WAIT_V(6); PG8_BAR; PG8_MMA(1, 1, At, B1); PG8_BAR;
            PG8_LDB(B0, 1, 0); PG8_SCHED; PG8_LDA(At, 1, 0); PG8_STAGE(PG8_SA(0, 1), a2 + hstepA, voffA);
            PG8_WAIT_L(8); PG8_BAR; PG8_WAIT_L(0); PG8_MMA(0, 0, At, B0); PG8_BAR; PG8_SCHED;
            PG8_LDB(B1, 1, 1); PG8_STAGE(PG8_SB(1, 0), b3, voffB);
            PG8_BAR; PG8_WAIT_L(0); PG8_MMA(0, 1, At, B1); PG8_BAR;
            PG8_LDA(At, 1, 1); PG8_STAGE(PG8_SA(1, 0), a3, voffA);
            PG8_BAR; PG8_WAIT_L(0); PG8_MMA(1, 0, At, B0); PG8_BAR; PG8_SCHED;
            PG8_STAGE(PG8_SB(1, 1), b3 + hstepB, voffB);
            PG8_WAIT_V(6); PG8_BAR; PG8_MMA(1, 1, At, B1); PG8_BAR;
        }
        gemm_epilogue(acc, g, cur, wr, wc, fr, fq);
        if (!has_next) break;
#pragma unroll
        for (int a = 0; a < 2; ++a)
#pragma unroll
            for (int b = 0; b < 2; ++b)
#pragma unroll
                for (int m = 0; m < 4; ++m)
#pragma unroll
                    for (int n = 0; n < 2; ++n) acc[a][b][m][n] = (f32x4){0.f, 0.f, 0.f, 0.f};
        cur = nxt; cA = nA; cB = nB; ++ui;
    }
    PG8_WAIT_V(0);
    if (wr == 0) PG8_BAR;
    PG8_BAR;
#undef PG8_SA
#undef PG8_SB
#undef PG8_STAGE
#undef PG8_LDA
#undef PG8_LDB
#undef PG8_MMA
#undef PG8_WAIT_V
#undef PG8_WAIT_L
#undef PG8_BAR
#undef PG8_SCHED
}

__device__ __forceinline__ int pair_row(int n) {
    if (n >= 8192) return n;
    const int seg = n >> 11, ch = n & 2047, t = ch >> 7, j = ch & 127;
    return ((seg & 1) ? 4096 : 0) + 256 * t + ((seg & 2) ? 128 : 0) + j;
}
template <bool PAIRMAP = false>
__device__ __forceinline__ void transpose_cvt(const int wbase, LAS unsigned char* lds, const float* __restrict__ src, int Kr, int Nc, bf16_t* __restrict__ dst) {
    constexpr int TP = 544;
    const int tid = opaque_tid(wbase), wid = tid >> 6, lane = tid & 63;
    const int npn = (Nc + 255) / 256, npk = Kr / 64, npan = npn * npk;
    const int kr = tid >> 3, q = tid & 7;
    const int g = lane >> 4, qq = (lane & 15) >> 2, pp = lane & 3;
    f32x4 v[8], vn[8];
    auto load_panel = [&](int idx, f32x4 (&dstv)[8]) {
        idx = idx < npan ? idx : npan - 1;
        const int n0 = (idx % npn) * 256, k0 = (idx / npn) * 64;
#pragma unroll
        for (int j = 0; j < 8; ++j) {
            int n = n0 + (q + 8 * j) * 4; n = n < Nc ? n : Nc - 4;
            dstv[j] = *(const f32x4*)(src + (size_t)(k0 + kr) * Nc + n);
        }
    };
    load_panel(blockIdx.x, v);
    for (int idx = blockIdx.x; idx < npan; idx += gridDim.x) {
        const int n0 = (idx % npn) * 256, k0 = (idx / npn) * 64;
        load_panel(idx + gridDim.x, vn);
        __syncthreads();
#pragma unroll
        for (int j = 0; j < 8; ++j) {
            u32x2 o; o[0] = cvt_pk_bf16(v[j][0], v[j][1]); o[1] = cvt_pk_bf16(v[j][2], v[j][3]);
            *(LAS u32x2*)(lds + kr * TP + (q + 8 * j) * 8) = o;
        }
        __syncthreads();
#pragma unroll
        for (int it = 0; it < 4; ++it) {
            const int f = wid * 4 + it, r0 = (f & 1) * 32, c0 = (f >> 1) * 16;
            LAS unsigned char* a0 = lds + (r0 + 8 * g + qq) * TP + c0 * 2 + 8 * pp;
            const s16x4 lo = __builtin_amdgcn_ds_read_tr16_b64_v4i16((LAS s16x4*)a0);
            const s16x4 hi = __builtin_amdgcn_ds_read_tr16_b64_v4i16((LAS s16x4*)(a0 + 4 * TP));
            const int n = n0 + c0 + (lane & 15);
            union { s16x4 h[2]; u32x4 u; } cv; cv.h[0] = lo; cv.h[1] = hi;
            if (n < Nc) *(u32x4*)(dst + (size_t)(PAIRMAP ? pair_row(n) : n) * Kr + k0 + r0 + 8 * g) = cv.u;
        }
#pragma unroll
        for (int j = 0; j < 8; ++j) v[j] = vn[j];
    }
    __syncthreads();
}

__device__ __forceinline__ void rmsnorm_to_bf16(const int wbase, const float* __restrict__ x, const float* __restrict__ w, bf16_t* __restrict__ out) {
    const int tid_ = opaque_tid(wbase); const int lane = tid_ & 63, wv = blockIdx.x * 8 + (tid_ >> 6), nwv = gridDim.x * 8;
    for (int row = wv; row < TOK; row += nwv) {
        f32x4 v[8]; float ss = 0.f;
#pragma unroll
        for (int i = 0; i < 8; ++i) { v[i] = *(const f32x4*)(x + (size_t)row * DM + i * 256 + lane * 4); ss += v[i][0] * v[i][0] + v[i][1] * v[i][1] + v[i][2] * v[i][2] + v[i][3] * v[i][3]; }
#pragma unroll
        for (int s = 32; s >= 1; s >>= 1) ss += __shfl_xor(ss, s);
        const float rs = rsqrtf(ss * (1.0f / DM) + EPS);
#pragma unroll
        for (int i = 0; i < 8; ++i) {
            const f32x4 w4 = *(const f32x4*)(w + i * 256 + lane * 4);
            u32x2 o; o[0] = cvt_pk_bf16(v[i][0] * rs * w4[0], v[i][1] * rs * w4[1]); o[1] = cvt_pk_bf16(v[i][2] * rs * w4[2], v[i][3] * rs * w4[3]);
            *(u32x2*)(out + (size_t)row * DM + i * 256 + lane * 4) = o;
        }
    }
}

template <bool TO_F32> __device__ __forceinline__ void rmsnorm_from_bf16(const int wbase, const bf16_t* __restrict__ x, const float* __restrict__ w, void* __restrict__ outp) {
    const int tid_ = opaque_tid(wbase); const int lane = tid_ & 63, wv = blockIdx.x * 8 + (tid_ >> 6), nwv = gridDim.x * 8;
    float nw[4][8];
#pragma unroll
    for (int i = 0; i < 4; ++i) {
        const int c8 = (i * 64 + lane) * 8;
        const f32x4 w0 = *(const f32x4*)(w + c8), w1 = *(const f32x4*)(w + c8 + 4);
#pragma unroll
        for (int e = 0; e < 8; ++e) nw[i][e] = e < 4 ? w0[e & 3] : w1[e & 3];
    }
    for (int row = wv; row < TOK; row += nwv) {
        float v[4][8]; float ss = 0.f;
#pragma unroll
        for (int i = 0; i < 4; ++i) {
            unpack8(*(const u32x4*)(x + (size_t)row * DM + (i * 64 + lane) * 8), v[i]);
#pragma unroll
            for (int e = 0; e < 8; ++e) ss += v[i][e] * v[i][e];
        }
#pragma unroll
        for (int s = 32; s >= 1; s >>= 1) ss += __shfl_xor(ss, s);
        const float rs = rsqrtf(ss * (1.0f / DM) + EPS);
#pragma unroll
        for (int i = 0; i < 4; ++i) {
            const int c8 = (i * 64 + lane) * 8;
            float o[8];
#pragma unroll
            for (int e = 0; e < 8; ++e) o[e] = v[i][e] * rs * nw[i][e];
            if (TO_F32) {
                float* op = (float*)outp + (size_t)row * DM + c8;
                *(f32x4*)op = (f32x4){o[0], o[1], o[2], o[3]}; *(f32x4*)(op + 4) = (f32x4){o[4], o[5], o[6], o[7]};
            } else *(u32x4*)((bf16_t*)outp + (size_t)row * DM + c8) = pack8(o);
        }
    }
}

__device__ __forceinline__ void build_dft(const int wbase, bf16_t* __restrict__ dft) {
    const size_t gt = (size_t)blockIdx.x * 512 + opaque_tid(wbase), nth = (size_t)gridDim.x * 512;
    for (size_t pidx = gt; pidx < (size_t)2048 * 256; pidx += nth) {
        const int k = (int)(pidx >> 8), j0 = (int)(pidx & 255) * 8;
        float f[8];
#pragma unroll
        for (int e = 0; e < 8; ++e) {
            const int j = j0 + e, l = j & 1023;
            const float ang = (float)((k * l) & 2047) * (1.0f / 1024.0f);
            f[e] = (j < 1024) ? cospif(ang) : -sinpif(ang);
        }
        *(u32x4*)(dft + (size_t)k * 2048 + j0) = pack8(f);
    }
}

__device__ __forceinline__ void fold_phase(const int wbase, const Params& p) {
    const bf16_t* bu = (const bf16_t*)(p.ws + WS_S0); bf16_t* uf = (bf16_t*)(p.ws + WS_UF);
    const bf16_t* w12 = (const bf16_t*)(p.ws + WS_W12); float* p1024 = (float*)(p.ws + WS_P1024);
    const size_t gt = (size_t)blockIdx.x * 512 + opaque_tid(wbase), nth = (size_t)gridDim.x * 512;
    for (size_t pc = gt; pc < (size_t)8 * 1024 * 256; pc += nth) {
        const int c8 = (int)(pc & 255) * 8, l = (int)(pc >> 8) & 1023, b = (int)(pc >> 18);
        float a[8], m[8], ue[8], uo[8];
        unpack8(*(const u32x4*)(bu + (size_t)(b * 2048 + l) * 2048 + c8), a);
        if (l > 0) {
            unpack8(*(const u32x4*)(bu + (size_t)(b * 2048 + 2048 - l) * 2048 + c8), m);
#pragma unroll
            for (int e = 0; e < 8; ++e) { ue[e] = a[e] + m[e]; uo[e] = a[e] - m[e]; }
        } else {
#pragma unroll
            for (int e = 0; e < 8; ++e) { ue[e] = a[e]; uo[e] = 0.f; }
        }
        *(u32x4*)(uf + (size_t)(b * 1024 + l) * 2048 + c8) = pack8(ue);
        *(u32x4*)(uf + (size_t)(8192 + b * 1024 + l) * 2048 + c8) = pack8(uo);
    }
    if (gt < 16384) {
        const int b = (int)(gt >> 11), ch = (int)(gt & 2047), g = ch >> 8, d = ch & 255;
        const bf16_t* up = bu + (size_t)(b * 2048 + 1024) * 2048 + g * 256; const bf16_t* wp = w12 + (size_t)g * 512 * 256 + (size_t)d * 256;
        float acc = 0.f;
#pragma unroll 4
        for (int c = 0; c < 256; c += 8) {
            float u[8], w[8]; unpack8(*(const u32x4*)(up + c), u); unpack8(*(const u32x4*)(wp + c), w);
#pragma unroll
            for (int e = 0; e < 8; ++e) acc += u[e] * w[e];
        }
        p1024[gt] = acc;
    }
}

__device__ __forceinline__ void build_w12(const int wbase, LAS unsigned char* lds, const float* __restrict__ fw, bf16_t* __restrict__ w12) {
    LAS float* fwl = (LAS float*)lds;
    LAS float* ctab = (LAS float*)(lds + 65536); LAS float* stab = ctab + 256;
    const int tid = opaque_tid(wbase), wid = tid >> 6, lane = tid & 63;
    const float scale = 1.0f / sqrtf(2048.0f * 256.0f);
    for (int task = blockIdx.x; task < 256; task += gridDim.x) {
        const int g = task >> 5, d0 = ((task >> 3) & 3) * 64, c0 = (task & 7) * 32;
        __syncthreads();
        if (tid < 256) { const float ang = (float)tid * (1.0f / 128.0f); ctab[tid] = cospif(ang); stab[tid] = sinpif(ang); }
#pragma unroll
        for (int j = 0; j < 8; ++j) {
            const int m = j * 32 + (tid >> 4), dd = (tid & 15) * 4;
            *(LAS f32x4*)(fwl + m * 64 + dd) = *(const f32x4*)(fw + (size_t)g * 65536 + (size_t)m * 256 + d0 + dd);
        }
        __syncthreads();
        const int cb = c0 + wid * 4;
        float ac[4] = {0.f, 0.f, 0.f, 0.f}, as[4] = {0.f, 0.f, 0.f, 0.f};
#pragma unroll 8
        for (int m = 0; m < 256; ++m) {
            const float v = fwl[m * 64 + lane];
#pragma unroll
            for (int cc = 0; cc < 4; ++cc) { const int ti = (m * (cb + cc)) & 255; ac[cc] += ctab[ti] * v; as[cc] += stab[ti] * v; }
        }
        bf16_t* o = w12 + (size_t)g * 512 * 256 + (size_t)(d0 + lane) * 256 + cb;
        u32x2 oc, os; oc[0] = cvt_pk_bf16(ac[0] * scale, ac[1] * scale); oc[1] = cvt_pk_bf16(ac[2] * scale, ac[3] * scale);
        os[0] = cvt_pk_bf16(as[0] * scale, as[1] * scale); os[1] = cvt_pk_bf16(as[2] * scale, as[3] * scale);
        *(u32x2*)o = oc; *(u32x2*)(o + 256 * 256) = os;
    }
    __syncthreads();
}

__device__ __forceinline__ void zero_fill16(const int wbase, unsigned char* p, size_t bytes) {
    const size_t gt = (size_t)blockIdx.x * 512 + opaque_tid(wbase), nth = (size_t)gridDim.x * 512;
    for (size_t i = gt; i < bytes / 16; i += nth) *(u32x4*)(p + i * 16) = (u32x4){0u, 0u, 0u, 0u};
}

__device__ __forceinline__ void gla_phase(const int wbase, LAS unsigned char* lds, const Params& p) {
    constexpr int G_OFF = 0, QIN_OFF = 16384, KIN_OFF = 25728, KET_OFF = 35072, VT_OFF = 44416, SC_OFF = 53760, EB_OFF = 56320;
    constexpr int TLD = 80;
    const int tid = opaque_tid(wbase), wid = __builtin_amdgcn_readfirstlane(tid >> 6), lane = tid & 63, fr = lane & 15, fq = lane >> 4;
    const int r = tid >> 4, c8 = (tid & 15) * 8;
    const bf16_t* qb = (const bf16_t*)(p.ws + WS_S0); const bf16_t* vb = (const bf16_t*)(p.ws + WS_S1);
    for (int item = blockIdx.x; item < 256; item += gridDim.x) {
        const int xcd = item & 7, slot = item >> 3, dir = slot & 1, bh = (slot >> 1) * 8 + xcd, b = bh >> 4, h = bh & 15;
        bf16_t* zb = (bf16_t*)(p.ws + (dir ? WS_S3 : WS_S2));
        float lb[8], oml[8];
#pragma unroll
        for (int e = 0; e < 8; ++e) {
            const int ch = h * 128 + c8 + e;
            const float l0 = p.lb_logits[ch], l1 = p.lb_logits[2048 + ch], l2 = p.lb_logits[4096 + ch];
            const float mx = fmaxf(l0, fmaxf(l1, l2)), e0 = __expf(l0 - mx), e1 = __expf(l1 - mx), e2 = __expf(l2 - mx);
            lb[e] = e0 / (e0 + e1 + e2); oml[e] = 1.0f - lb[e];
        }
        f32x4 accS[8];
#pragma unroll
        for (int i = 0; i < 8; ++i) accS[i] = (f32x4){0.f, 0.f, 0.f, 0.f};
        __syncthreads();
        if (tid < 64) *(LAS u32x2*)(lds + SC_OFF + (tid >> 2) * TLD + 32 + (tid & 3) * 8) = (u32x2){0u, 0u};
        const size_t colo = (size_t)h * 128 + c8;
        auto row_of = [&](int c, int rr) -> size_t { const int tt = c * 32 + rr; const int t = dir ? (SEQ - 1 - tt) : tt; return (size_t)(b * SEQ + t) * DM; };
        u32x4 rq, rv, rz;
        { const size_t ro = row_of(0, r) + colo; rq = *(const u32x4*)(qb + ro); rv = *(const u32x4*)(vb + ro); rz = *(const u32x4*)(zb + ro); }
        for (int c = 0; c < SEQ / 32; ++c) {
            float qf[8], zf[8], kf[8];
            unpack8(rq, qf); unpack8(rz, zf);
            const u32x4 vcur = rv;
            {
                float gf[8];
#pragma unroll
                for (int e = 0; e < 8; ++e) {
                    const float s = __builtin_amdgcn_rcpf(1.0f + __expf(-zf[e]));
                    const float f = lb[e] + oml[e] * s;
                    gf[e] = __logf(f); kf[e] = oml[e] * (1.0f - s);
                }
                *(LAS f32x4*)(lds + G_OFF + r * 512 + c8 * 4) = (f32x4){gf[0], gf[1], gf[2], gf[3]};
                *(LAS f32x4*)(lds + G_OFF + r * 512 + c8 * 4 + 16) = (f32x4){gf[4], gf[5], gf[6], gf[7]};
            }
            if (c + 1 < SEQ / 32) { const size_t ro = row_of(c + 1, r) + colo; rq = *(const u32x4*)(qb + ro); rv = *(const u32x4*)(vb + ro); rz = *(const u32x4*)(zb + ro); }
            __syncthreads();
            if (tid < 128) {
                float run = 0.f;
#pragma unroll
                for (int rr = 0; rr < 32; ++rr) { LAS float* gp = (LAS float*)(lds + G_OFF + rr * 512 + tid * 4); run += *gp; *gp = run; }
                *(LAS float*)(lds + EB_OFF + tid * 4) = __expf(run);
            }
            __syncthreads();
            {
                const f32x4 b0 = *(LAS f32x4*)(lds + G_OFF + r * 512 + c8 * 4), b1 = *(LAS f32x4*)(lds + G_OFF + r * 512 + c8 * 4 + 16);
                const f32x4 l0 = *(LAS f32x4*)(lds + EB_OFF + c8 * 4), l1 = *(LAS f32x4*)(lds + EB_OFF + c8 * 4 + 16);
                float qi[8], ki[8], ke[8];
#pragma unroll
                for (int e = 0; e < 8; ++e) {
                    const float bc = e < 4 ? b0[e & 3] : b1[e & 3], ebl = e < 4 ? l0[e & 3] : l1[e & 3];
                    qi[e] = qf[e] * __expf(bc); ki[e] = kf[e] * __expf(-bc); ke[e] = ki[e] * ebl;
                }
                *(LAS u32x4*)(lds + QIN_OFF + rowaddr(r) + c8 * 2) = pack8(qi);
                *(LAS u32x4*)(lds + KIN_OFF + rowaddr(r) + c8 * 2) = pack8(ki);
                *(LAS u32x4*)(lds + KET_OFF + rowaddr(r) + c8 * 2) = pack8(ke);
                *(LAS u32x4*)(lds + VT_OFF + rowaddr(r) + c8 * 2) = vcur;
            }
            __syncthreads();
            if (wid < 3) {
                const int mt = wid >= 1 ? 1 : 0, ntl = wid == 2 ? 1 : 0;
                f32x4 sacc = (f32x4){0.f, 0.f, 0.f, 0.f};
#pragma unroll
                for (int kk = 0; kk < 4; ++kk) {
                    const bf16x8 a = lds_b128(lds + KIN_OFF + rowaddr(ntl * 16 + fr) + (kk * 32 + fq * 8) * 2);
                    const bf16x8 bq = lds_b128(lds + QIN_OFF + rowaddr(mt * 16 + fr) + (kk * 32 + fq * 8) * 2);
                    sacc = MFMA16(a, bq, sacc);
                }
                const int i = mt * 16 + fr, j0 = ntl * 16 + fq * 4;
                u32x2 o; o[0] = cvt_pk_bf16(j0 + 0 <= i ? sacc[0] : 0.f, j0 + 1 <= i ? sacc[1] : 0.f); o[1] = cvt_pk_bf16(j0 + 2 <= i ? sacc[2] : 0.f, j0 + 3 <= i ? sacc[3] : 0.f);
                *(LAS u32x2*)(lds + SC_OFF + i * TLD + j0 * 2) = o;
            }
            f32x4 oacc[2]; oacc[0] = (f32x4){0.f, 0.f, 0.f, 0.f}; oacc[1] = oacc[0];
#pragma unroll
            for (int pp = 0; pp < 4; ++pp) {
                const bf16x8 sa = pack_acc2(accS[2 * pp], accS[2 * pp + 1]);
#pragma unroll
                for (int mt = 0; mt < 2; ++mt) {
                    LAS unsigned char* qp = lds + QIN_OFF + rowaddr(mt * 16 + fr) + (pp * 32 + fq * 4) * 2;
                    const bf16x8 bq = lds_2xb64(qp, qp + 32);
                    oacc[mt] = MFMA16(sa, bq, oacc[mt]);
                }
            }
            __syncthreads();
            {
                const bf16x8 va = lds_tr_frag(lds + VT_OFF, 0, wid * 16, lane);
#pragma unroll
                for (int mt = 0; mt < 2; ++mt) {
                    const bf16x8 sb = lds_b128(lds + SC_OFF + (mt * 16 + fr) * TLD + fq * 16);
                    oacc[mt] = MFMA16(va, sb, oacc[mt]);
                    u32x2 o; o[0] = cvt_pk_bf16(oacc[mt][0], oacc[mt][1]); o[1] = cvt_pk_bf16(oacc[mt][2], oacc[mt][3]);
                    *(u32x2*)(zb + row_of(c, mt * 16 + fr) + (size_t)h * 128 + wid * 16 + fq * 4) = o;
                }
#pragma unroll
                for (int kt = 0; kt < 8; ++kt) {
                    const f32x4 e4 = *(LAS f32x4*)(lds + EB_OFF + (kt * 16 + fq * 4) * 4);
                    accS[kt] = accS[kt] * e4;
                    accS[kt] = MFMA16(lds_tr_frag(lds + KET_OFF, 0, kt * 16, lane), va, accS[kt]);
                }
            }
        }
        __syncthreads();
    }
}

__device__ __forceinline__ void post_a_phase(const int wbase, const Params& p) {
    const bf16_t* of = (const bf16_t*)(p.ws + WS_S2); const bf16_t* ob = (const bf16_t*)(p.ws + WS_S3);
    bf16_t* mix = (bf16_t*)p.out;
    const size_t gt = (size_t)blockIdx.x * 512 + opaque_tid(wbase), nth = (size_t)gridDim.x * 512;
    for (size_t pc = gt; pc < (size_t)TOK * 256; pc += 2 * nth) {
        u32x4 ra[2], rb[2], rg[2];
#pragma unroll
        for (int u = 0; u < 2; ++u) {
            const size_t q = pc + u * nth; const size_t tok = q >> 8; const int c8 = (int)(q & 255) * 8;
            ra[u] = *(const u32x4*)(of + tok * DM + c8); rb[u] = *(const u32x4*)(ob + tok * DM + c8); rg[u] = *(const u32x4*)(mix + tok * 4096 + c8);
        }
#pragma unroll
        for (int u = 0; u < 2; ++u) {
            const size_t q = pc + u * nth; const size_t tok = q >> 8; const int c8 = (int)(q & 255) * 8;
            float a[8], bb[8], gte[8];
            unpack8(ra[u], a); unpack8(rb[u], bb); unpack8(rg[u], gte);
            float ss = 0.f;
#pragma unroll
            for (int e = 0; e < 8; ++e) { a[e] += bb[e]; ss += a[e] * a[e]; }
            ss += __shfl_xor(ss, 1); ss += __shfl_xor(ss, 2); ss += __shfl_xor(ss, 4); ss += __shfl_xor(ss, 8);
            const float rs = rsqrtf(ss * (1.0f / 128.0f) + EPS);
            const f32x4 w0 = *(const f32x4*)(p.hgrn_norm_w + c8), w1 = *(const f32x4*)(p.hgrn_norm_w + c8 + 4);
            float o[8];
#pragma unroll
            for (int e = 0; e < 8; ++e) o[e] = a[e] * rs * (e < 4 ? w0[e & 3] : w1[e & 3]) * silu_f(gte[e]);
            *(u32x4*)(mix + tok * 4096 + c8) = pack8(o);
        }
    }
}

__device__ __forceinline__ void conv_c_phase(const int wbase, const Params& p) {
    const bf16_t* uu = (const bf16_t*)(p.ws + WS_CIN);
    bf16_t* mix = (bf16_t*)p.out;
    const size_t gt = (size_t)blockIdx.x * 512 + opaque_tid(wbase), nth = (size_t)gridDim.x * 512;
    for (size_t pc0 = gt; pc0 < (size_t)TOK * 256; pc0 += 2 * nth) {
        u32x4 ru[2][3], rw[2];
#pragma unroll
        for (int h = 0; h < 2; ++h) {
            const size_t pc = pc0 + h * nth; const size_t tok = pc >> 8; const int c8 = (int)(pc & 255) * 8; const int t = (int)(tok & (SEQ - 1));
#pragma unroll
            for (int k = 0; k < 3; ++k) {
                const int tt = t + k - 1;
                ru[h][k] = (tt >= 0 && tt < SEQ) ? *(const u32x4*)(uu + (tok + k - 1) * DM + c8) : (u32x4){0u, 0u, 0u, 0u};
            }
            rw[h] = *(const u32x4*)(mix + tok * 4096 + c8);
        }
#pragma unroll
        for (int h = 0; h < 2; ++h) {
            const size_t pc = pc0 + h * nth; const size_t tok = pc >> 8; const int c8 = (int)(pc & 255) * 8;
            float acc[8];
#pragma unroll
            for (int e = 0; e < 8; ++e) acc[e] = 0.f;
#pragma unroll
            for (int k = 0; k < 3; ++k) {
                float u[8]; unpack8(ru[h][k], u);
                const f32x4 w0 = *(const f32x4*)(p.sconv_w + k * DM + c8), w1 = *(const f32x4*)(p.sconv_w + k * DM + c8 + 4);
#pragma unroll
                for (int e = 0; e < 8; ++e) acc[e] += u[e] * (e < 4 ? w0[e & 3] : w1[e & 3]);
            }
            float wv[8]; unpack8(rw[h], wv);
            float o[8];
#pragma unroll
            for (int e = 0; e < 8; ++e) o[e] = wv[e] * acc[e];
            *(u32x4*)(mix + tok * 4096 + c8) = pack8(o);
        }
    }
}

__device__ __forceinline__ void preconv_phase(const int wbase, const Params& p) {
    const bf16_t* xbc = (const bf16_t*)(p.ws + WS_XBC); bf16_t* xact = (bf16_t*)(p.ws + WS_XACT); bf16_t* bcact = (bf16_t*)(p.ws + WS_BCACT);
    const size_t gt = (size_t)blockIdx.x * 512 + opaque_tid(wbase), nth = (size_t)gridDim.x * 512;
    for (size_t pc = gt; pc < (size_t)(TOK / 4) * 384; pc += nth) {
        const int cg = (int)(pc % 384), c8 = cg * 8; const size_t tok0 = (pc / 384) * 4; const int t0 = (int)(tok0 & (SEQ - 1));
        u32x4 raw[6];
#pragma unroll
        for (int j = 0; j < 6; ++j) { const int t = t0 - 1 + j; raw[j] = (t >= 0 && t < SEQ) ? *(const u32x4*)(xbc + (tok0 + j - 1) * 3072 + c8) : (u32x4){0u, 0u, 0u, 0u}; }
        float w0[8], w1[8], w2[8], cb[8];
        { const f32x4 a0 = *(const f32x4*)(p.ssd_conv_w + c8), a1 = *(const f32x4*)(p.ssd_conv_w + c8 + 4), b0 = *(const f32x4*)(p.ssd_conv_w + 3072 + c8), b1 = *(const f32x4*)(p.ssd_conv_w + 3072 + c8 + 4),
                      c0 = *(const f32x4*)(p.ssd_conv_w + 6144 + c8), c1 = *(const f32x4*)(p.ssd_conv_w + 6144 + c8 + 4), d0 = *(const f32x4*)(p.ssd_conv_b + c8), d1 = *(const f32x4*)(p.ssd_conv_b + c8 + 4);
#pragma unroll
          for (int e = 0; e < 8; ++e) { w0[e] = e < 4 ? a0[e & 3] : a1[e & 3]; w1[e] = e < 4 ? b0[e & 3] : b1[e & 3]; w2[e] = e < 4 ? c0[e & 3] : c1[e & 3]; cb[e] = e < 4 ? d0[e & 3] : d1[e & 3]; } }
        float prev[8], cur[8], nxt[8], val[8];
        unpack8(raw[0], prev); unpack8(raw[1], cur);
#pragma unroll
        for (int j = 0; j < 4; ++j) {
            unpack8(raw[j + 2], nxt);
#pragma unroll
            for (int e = 0; e < 8; ++e) { val[e] = silu_f(w0[e] * prev[e] + w1[e] * cur[e] + w2[e] * nxt[e] + cb[e]); prev[e] = cur[e]; cur[e] = nxt[e]; }
            if (c8 < 2048) *(u32x4*)(xact + (tok0 + j) * 2048 + c8) = pack8(val);
            else *(u32x4*)(bcact + (tok0 + j) * 1024 + (c8 - 2048)) = pack8(val);
        }
    }
}

__device__ __forceinline__ void ssd_phase(const int wbase, LAS unsigned char* lds, const Params& p) {
    constexpr int CS_OFF = 0, BS_OFF = 18560, XS_OFF = 37120, XWS_OFF = 55680, MT_OFF = 74240, ACUM_OFF = 92672, DTV_OFF = 93696;
    constexpr int JLD = 144, HDS = 64 * 144;
    const int tid = opaque_tid(wbase), wid = __builtin_amdgcn_readfirstlane(tid >> 6), lane = tid & 63, fr = lane & 15, fq = lane >> 4;
    const int hd = wid >> 2, wv = wid & 3;
    const bf16_t* xbc = (const bf16_t*)(p.ws + WS_XBC); const bf16_t* dtb = (const bf16_t*)(p.ws + WS_DT);
    for (int item = blockIdx.x; item < 256; item += gridDim.x) {
        const int xcd = item & 7, slot = item >> 3, bg = xcd * 4 + (slot >> 3), b = bg >> 2, grp = bg & 3, sub = slot & 7, dir = sub & 1, pair = sub >> 1;
        const int head0 = grp * 8 + pair * 2, head = head0 + hd;
        bf16_t* yb = (bf16_t*)(p.ws + (dir ? WS_YB : WS_YF));
        const int cg = tid & 15, lrow = tid >> 4;
        const bf16_t* xact = (const bf16_t*)(p.ws + WS_XACT); const bf16_t* bcact = (const bf16_t*)(p.ws + WS_BCACT);
        const float dtbias = p.dt_bias[dir * 32 + head], Acoef = -__expf(p.a_log[dir * 32 + head]);
        f32x4 accS[8];
#pragma unroll
        for (int i = 0; i < 8; ++i) accS[i] = (f32x4){0.f, 0.f, 0.f, 0.f};
        __syncthreads();
        if (tid < 256) { const int hh = tid >> 7, which = (tid >> 6) & 1, rr = (tid >> 2) & 15, cq = tid & 3;
            *(LAS u32x2*)(lds + MT_OFF + hh * HDS + (which * 32 + rr) * JLD + (which * 32 + 16 + cq * 4) * 2) = (u32x2){0u, 0u}; }
        u32x4 raw[6]; unsigned rawdt = 0;
        auto load_chunk = [&](int c) {
            const int t0 = dir ? (SEQ - 64 * (c + 1)) : 64 * c;
            if (wv == 0) { const int t = dir ? (t0 + 63 - lane) : (t0 + lane); rawdt = dtb[(size_t)(b * SEQ + t) * 256 + dir * 32 + head]; }
#pragma unroll
            for (int j = 0; j < 6; ++j) {
                const int i = lrow + 32 * (j & 1), t = t0 + (dir ? 63 - i : i);
                const size_t row = (size_t)(b * SEQ + t);
                raw[j] = (j < 2) ? *(const u32x4*)(xact + row * 2048 + head0 * 64 + cg * 8)
                                 : *(const u32x4*)(bcact + row * 1024 + (j < 4 ? 0 : 512) + grp * 128 + cg * 8);
            }
        };
        load_chunk(0);
        {
            const int t00 = dir ? (SEQ - 64) : 0;
#pragma unroll
            for (int it = 0; it < 4; ++it) { const int i = it * 16 + fr, tt = dir ? 63 - i : i;
                *(u32x2*)(yb + (size_t)(b * SEQ + t00 + tt) * DM + head * 64 + wv * 16 + fq * 4) = (u32x2){0u, 0u}; }
        }
        for (int c = 0; c < SEQ / 64; ++c) {
            const int t0 = dir ? (SEQ - 64 * (c + 1)) : 64 * c;
            const int par = c & 1;
            LAS float* acum = (LAS float*)(lds + ACUM_OFF + par * 512 + hd * 256);
            LAS float* dtv = (LAS float*)(lds + DTV_OFF + par * 512 + hd * 256);
            if (wv == 0) {
                const float xr = bf_lo(rawdt) + dtbias;
                const float dtval = fmaxf(xr, 0.f) + __logf(1.0f + __expf(-fabsf(xr)));
                float a = dtval * Acoef;
                a += __builtin_bit_cast(float, __builtin_amdgcn_update_dpp(0, __builtin_bit_cast(int, a), 0x111, 0xf, 0xf, false));
                a += __builtin_bit_cast(float, __builtin_amdgcn_update_dpp(0, __builtin_bit_cast(int, a), 0x112, 0xf, 0xf, false));
                a += __builtin_bit_cast(float, __builtin_amdgcn_update_dpp(0, __builtin_bit_cast(int, a), 0x114, 0xf, 0xf, false));
                a += __builtin_bit_cast(float, __builtin_amdgcn_update_dpp(0, __builtin_bit_cast(int, a), 0x118, 0xf, 0xf, false));
                a += __builtin_bit_cast(float, __builtin_amdgcn_update_dpp(0, __builtin_bit_cast(int, a), 0x142, 0xa, 0xf, false));
                a += __builtin_bit_cast(float, __builtin_amdgcn_update_dpp(0, __builtin_bit_cast(int, a), 0x143, 0xc, 0xf, false));
                acum[lane] = a; dtv[lane] = dtval;
            }
            __syncthreads();
            {
                const int xh = cg >> 3;
                LAS float* ac2 = (LAS float*)(lds + ACUM_OFF + par * 512 + xh * 256); LAS float* dt2 = (LAS float*)(lds + DTV_OFF + par * 512 + xh * 256);
                const float alast = ac2[63];
#pragma unroll
                for (int j = 0; j < 6; ++j) {
                    const int i = lrow + 32 * (j & 1);
                    const int aoff = (j < 2 ? XS_OFF : (j < 4 ? BS_OFF : CS_OFF)) + cg * 16 + rowaddr(i);
                    *(LAS u32x4*)(lds + aoff) = raw[j];
                    if (j < 2) {
                        const float wgt = __expf(alast - ac2[i]) * dt2[i];
                        float val[8]; unpack8(raw[j], val);
#pragma unroll
                        for (int e = 0; e < 8; ++e) val[e] *= wgt;
                        *(LAS u32x4*)(lds + (XWS_OFF - XS_OFF) + aoff) = pack8(val);
                    }
                }
            }
            if (c + 1 < SEQ / 64) load_chunk(c + 1);
            __syncthreads();
            for (int ti = wid; ti < 10; ti += 8) {
                const int it = ti < 1 ? 0 : (ti < 3 ? 1 : (ti < 6 ? 2 : 3)), jt = ti - (it * (it + 1)) / 2;
                f32x4 cacc = (f32x4){0.f, 0.f, 0.f, 0.f};
#pragma unroll
                for (int kk = 0; kk < 4; ++kk) {
                    const bf16x8 a = lds_b128(lds + BS_OFF + rowaddr(jt * 16 + fr) + (kk * 32 + fq * 8) * 2);
                    const bf16x8 bb = lds_b128(lds + CS_OFF + rowaddr(it * 16 + fr) + (kk * 32 + fq * 8) * 2);
                    cacc = MFMA16(a, bb, cacc);
                }
                const int i = it * 16 + fr, j0 = jt * 16 + fq * 4;
#pragma unroll
                for (int hh = 0; hh < 2; ++hh) {
                    LAS float* ac = (LAS float*)(lds + ACUM_OFF + par * 512 + hh * 256); LAS float* dv = (LAS float*)(lds + DTV_OFF + par * 512 + hh * 256);
                    const float ai = ac[i];
                    const f32x4 aj = *(LAS f32x4*)(ac + j0), dj = *(LAS f32x4*)(dv + j0);
                    float m[4];
#pragma unroll
                    for (int e = 0; e < 4; ++e) m[e] = (j0 + e <= i) ? cacc[e] * __expf(ai - aj[e]) * dj[e] : 0.f;
                    u32x2 o; o[0] = cvt_pk_bf16(m[0], m[1]); o[1] = cvt_pk_bf16(m[2], m[3]);
                    *(LAS u32x2*)(lds + MT_OFF + hh * HDS + i * JLD + j0 * 2) = o;
                }
            }
            f32x4 yint[4], yacc[4];
#pragma unroll
            for (int it = 0; it < 4; ++it) { yint[it] = (f32x4){0.f, 0.f, 0.f, 0.f}; yacc[it] = yint[it]; }
#pragma unroll
            for (int pp = 0; pp < 4; ++pp) {
                const bf16x8 sa = pack_acc2(accS[2 * pp], accS[2 * pp + 1]);
#pragma unroll
                for (int it = 0; it < 4; ++it) {
                    LAS unsigned char* cp = lds + CS_OFF + rowaddr(it * 16 + fr) + (pp * 32 + fq * 4) * 2;
                    yint[it] = MFMA16(sa, lds_2xb64(cp, cp + 32), yint[it]);
                }
            }
            __syncthreads();
            {
                const int pt = wv, pc0 = hd * 64 + pt * 16;
                const bf16x8 xa0 = lds_tr_frag(lds + XS_OFF, 0, pc0, lane), xa1 = lds_tr_frag(lds + XS_OFF, 32, pc0, lane);
#pragma unroll
                for (int it = 0; it < 4; ++it) {
                    yacc[it] = MFMA16(xa0, lds_b128(lds + MT_OFF + hd * HDS + (it * 16 + fr) * JLD + fq * 16), yacc[it]);
                    if (it >= 2) yacc[it] = MFMA16(xa1, lds_b128(lds + MT_OFF + hd * HDS + (it * 16 + fr) * JLD + (32 + fq * 8) * 2), yacc[it]);
                    const int i = it * 16 + fr; const float ei = __expf(acum[i]);
                    const int tt = dir ? 63 - i : i;
                    u32x2 o; o[0] = cvt_pk_bf16(yacc[it][0] + ei * yint[it][0], yacc[it][1] + ei * yint[it][1]); o[1] = cvt_pk_bf16(yacc[it][2] + ei * yint[it][2], yacc[it][3] + ei * yint[it][3]);
                    *(u32x2*)(yb + (size_t)(b * SEQ + t0 + tt) * DM + head * 64 + pt * 16 + fq * 4) = o;
                }
                const float sc = __expf(acum[63]);
                const bf16x8 xw0 = lds_tr_frag(lds + XWS_OFF, 0, pc0, lane), xw1 = lds_tr_frag(lds + XWS_OFF, 32, pc0, lane);
#pragma unroll
                for (int nt = 0; nt < 8; ++nt) {
                    accS[nt] = accS[nt] * sc;
                    accS[nt] = MFMA16(lds_tr_frag(lds + BS_OFF, 0, nt * 16, lane), xw0, accS[nt]);
                    accS[nt] = MFMA16(lds_tr_frag(lds + BS_OFF, 32, nt * 16, lane), xw1, accS[nt]);
                }
            }
        }
        __syncthreads();
    }
}

__device__ __forceinline__ void post_d_phase(const int wbase, const Params& p) {
    const bf16_t* yf = (const bf16_t*)(p.ws + WS_YF); const bf16_t* yb = (const bf16_t*)(p.ws + WS_YB); const bf16_t* xact = (const bf16_t*)(p.ws + WS_XACT);
    bf16_t* mix = (bf16_t*)p.out;
    const int tid_ = opaque_tid(wbase); const int lane = tid_ & 63, wv = blockIdx.x * 8 + (tid_ >> 6), nwv = gridDim.x * 8;
    float nw[4][8], dskv[4];
#pragma unroll
    for (int i = 0; i < 4; ++i) {
        const int c8 = (i * 64 + lane) * 8;
        const f32x4 w0 = *(const f32x4*)(p.ssd_norm_w + c8), w1 = *(const f32x4*)(p.ssd_norm_w + c8 + 4);
#pragma unroll
        for (int e = 0; e < 8; ++e) nw[i][e] = e < 4 ? w0[e & 3] : w1[e & 3];
        dskv[i] = p.ssd_d[c8 >> 6];
    }
#pragma unroll 1
    for (int tok = wv; tok < TOK; tok += nwv) {
        float y[4][8]; float ss = 0.f;
#pragma unroll
        for (int i = 0; i < 4; ++i) {
            const int c8 = (i * 64 + lane) * 8;
            float a[8], bb[8], z[8], s[8];
            unpack8(*(const u32x4*)(yf + (size_t)tok * DM + c8), a); unpack8(*(const u32x4*)(yb + (size_t)tok * DM + c8), bb);
            unpack8(*(const u32x4*)(mix + (size_t)tok * 4096 + 2048 + c8), z);
            unpack8(*(const u32x4*)(xact + (size_t)tok * DM + c8), s);
            const float dsk = dskv[i];
#pragma unroll
            for (int e = 0; e < 8; ++e) { const float v = (a[e] + bb[e] + s[e] * dsk) * silu_f(z[e]); y[i][e] = v; ss += v * v; }
            __builtin_amdgcn_sched_barrier(0);
        }
#pragma unroll
        for (int s = 32; s >= 1; s >>= 1) ss += __shfl_xor(ss, s);
        const float rs = rsqrtf(ss * (1.0f / DM) + EPS);
#pragma unroll
        for (int i = 0; i < 4; ++i) {
            const int c8 = (i * 64 + lane) * 8;
            float o[8];
#pragma unroll
            for (int e = 0; e < 8; ++e) o[e] = y[i][e] * rs * nw[i][e];
            *(u32x4*)(mix + (size_t)tok * 4096 + 2048 + c8) = pack8(o);
        }
    }
}


#define XB_TMO      128
#define XB_XCNT(j)  (256  + 64 * (j))
#define XB_XSUB(j)  (1280 + 64 * (j))
#define XB_XGEN(j)  (2304 + 64 * (j))
#define XB_TOP      3328
#define XB_TOPGEN   3392
#define XCD_BAR_WORDS 3456
#define XB_SPIN_CAP (1u << 18)
constexpr size_t WS_BAR = 504 * MiB;
__device__ __forceinline__ unsigned xb_ld(unsigned* p)              { return __hip_atomic_load(p, __ATOMIC_RELAXED, __HIP_MEMORY_SCOPE_AGENT); }
__device__ __forceinline__ unsigned xb_add(unsigned* p, unsigned v) { return __hip_atomic_fetch_add(p, v, __ATOMIC_RELAXED, __HIP_MEMORY_SCOPE_AGENT); }
__device__ __forceinline__ unsigned xb_xcc_id() { return (unsigned)__builtin_amdgcn_s_getreg((3 << 11) | 20) & 0xFu; }
#define XB_SPIN(cond, bar) do { unsigned _sp = 0; while (cond) { __builtin_amdgcn_s_sleep(1); \
    if ((++_sp & 255u) == 0u) { if (xb_ld(&(bar)[XB_TMO])) break; if (_sp > XB_SPIN_CAP) { atomicAdd(&(bar)[XB_TMO], 1u); break; } } } } while (0)
struct XcdBarrier { unsigned* bar; unsigned x; volatile LAS unsigned* st; };
__device__ __forceinline__ XcdBarrier xcd_barrier_post(unsigned* bar, volatile LAS unsigned* st) {
    XcdBarrier b; b.bar = bar; b.x = xb_xcc_id(); b.st = st;
    if (threadIdx.x == 0) (void)xb_add(&bar[XB_XCNT(b.x)], 1u);
    return b;
}
__device__ __forceinline__ void xcd_barrier_complete(unsigned* bar, unsigned x, unsigned& nloc, unsigned& nx) {
    const unsigned G = gridDim.x * gridDim.y * gridDim.z;
    unsigned sum, cnt, mine, sp = 0u;
    for (;;) {
        sum = 0u; cnt = 0u; mine = 0u;
#pragma unroll
        for (unsigned j = 0; j < 16; ++j) { const unsigned c = xb_ld(&bar[XB_XCNT(j)]); sum += c; cnt += (c > 0u) ? 1u : 0u; mine = (j == x) ? c : mine; }
        if (sum == G) break;
        __builtin_amdgcn_s_sleep(1);
        if ((++sp & 255u) == 0u) { if (xb_ld(&bar[XB_TMO])) break; if (sp > XB_SPIN_CAP) { atomicAdd(&bar[XB_TMO], 1u); break; } }
    }
    nloc = mine > 0u ? mine : 1u; nx = cnt > 0u ? cnt : 1u;
}
__device__ __forceinline__ void xcd_barrier(const int wbase, const XcdBarrier& b) {
    asm volatile("s_waitcnt vmcnt(0)" ::: "memory");
    __syncthreads();
    if (opaque_tid(wbase) == 0) {
        unsigned* bar = b.bar;
        __builtin_amdgcn_s_waitcnt(0);
        unsigned nloc = b.st[0], nx = b.st[1];
        if (nloc == 0u) { xcd_barrier_complete(bar, b.x, nloc, nx); b.st[0] = nloc; b.st[1] = nx; }
        const unsigned old = xb_add(&bar[XB_XSUB(b.x)], 1u);
        const unsigned gen = old / nloc;
        if (old + 1u == (gen + 1u) * nloc) {
            __builtin_amdgcn_fence(__ATOMIC_RELEASE, "agent");
            asm volatile("s_waitcnt vmcnt(0)" ::: "memory");
            const unsigned og = xb_add(&bar[XB_TOP], 1u);
            const unsigned tg = og / nx;
            if (og + 1u == (tg + 1u) * nx) xb_add(&bar[XB_TOPGEN], 1u);
            else XB_SPIN(xb_ld(&bar[XB_TOPGEN]) == tg, bar);
            __builtin_amdgcn_fence(__ATOMIC_ACQUIRE, "agent");
            xb_add(&bar[XB_XGEN(b.x)], 1u);
            asm volatile("s_waitcnt vmcnt(0)" ::: "memory");
        } else {
            XB_SPIN(xb_ld(&bar[XB_XGEN(b.x)]) == gen, bar);
            __builtin_amdgcn_fence(__ATOMIC_ACQUIRE, "agent");
            asm volatile("s_waitcnt vmcnt(0)" ::: "memory");
        }
    }
    __syncthreads();
}

constexpr int NPHASE = 18;
__global__ void __launch_bounds__(512, 2) fwd_megakernel(Params p) {
    extern __shared__ __attribute__((aligned(16))) unsigned char shm[];
    LAS unsigned char* lds = (LAS unsigned char*)shm;
    cg::grid_group grid = cg::this_grid();
    const int wbase = __builtin_amdgcn_readfirstlane((int)(threadIdx.x >> 6)) * 64;
    if (threadIdx.x == 0) { ((volatile LAS unsigned*)(lds + 131072))[0] = 0u; ((volatile LAS unsigned*)(lds + 131072))[1] = 0u; }
    __syncthreads();
    XcdBarrier bar = xcd_barrier_post((unsigned*)(p.ws + WS_BAR), (volatile LAS unsigned*)(lds + 131072));
    if (p.ph_lo < 0) grid.sync();
    unsigned char* ws = p.ws;
    bf16_t* mix = (bf16_t*)p.out;
#define PH_BEGIN(k) if (p.ph_lo <= (k) && (k) < p.ph_hi) { if ((k) > p.ph_lo) xcd_barrier(wbase, bar);
#define PH_GEMM(k) PH_BEGIN(k) GemmJob g; \
        g.A = nullptr; g.Bt = nullptr; g.lda = g.ldb = 2048; g.nM = g.nN = 1; g.K = 2048; g.mode = MODE_SEG; \
        g.strideAz = 0; g.strideBz = 0; g.strideBpm = 0; g.Z = 1; g.c0 = g.c1 = g.c2 = g.c3 = g.c4 = nullptr; g.ld0 = g.ld1 = g.ld2 = g.ld3 = g.ld4 = 2048; \
        g.t1 = g.t2 = g.t3 = g.t4 = 1 << 20; g.fbias = nullptr; g.resid = nullptr; g.outf = nullptr;
#define PH_END }
    PH_BEGIN(0)
        transpose_cvt(wbase, lds, p.ev_w_in, 2048, 14336, (bf16_t*)(ws + WS_WIN));
        transpose_cvt(wbase, lds, p.ev_w_out, 4096, 2048, (bf16_t*)(ws + WS_WOUT));
        build_dft(wbase, (bf16_t*)(ws + WS_DFT));
        build_w12(wbase, lds, p.fnet_w, (bf16_t*)(ws + WS_W12));
        rmsnorm_to_bf16(wbase, p.x, p.norm_w, (bf16_t*)(ws + WS_H));
    PH_END
    PH_GEMM(1)
        g.A = (const char*)(ws + WS_H); g.Bt = (const char*)(ws + WS_WIN) + (size_t)10240 * 2048 * 2; g.lda = 2048; g.ldb = 2048; g.nM = 64; g.nN = 16; g.K = 2048; g.mode = MODE_SEG;
        g.c0 = (bf16_t*)(ws + WS_S0); g.ld0 = 2048; g.c1 = mix + 2048; g.ld1 = 4096; g.t1 = 8;
        gemm_phase(wbase, lds, g);
    PH_END
    PH_BEGIN(2) fold_phase(wbase, p); PH_END
    PH_GEMM(3)
        g.A = (const char*)(ws + WS_W12); g.strideAz = (size_t)512 * 256 * 2; g.lda = 256; g.Bt = (const char*)(ws + WS_UF); g.strideBz = 256 * 2; g.ldb = 2048; g.strideBpm = (size_t)8192 * 2048 * 2;
        g.nM = 2; g.nN = 32; g.Z = 8; g.K = 256; g.mode = MODE_PT; g.c0 = (bf16_t*)(ws + WS_S2);
        gemm_phase(wbase, lds, g);
    PH_END
    PH_GEMM(4)
        g.A = (const char*)(ws + WS_DFT); g.lda = 2048; g.Bt = (const char*)(ws + WS_S2); g.strideBz = (size_t)2048 * 2048 * 2; g.ldb = 2048;
        g.nM = 8; g.nN = 8; g.Z = 8; g.K = 2048; g.mode = MODE_DFT; g.c0 = mix; g.fbias = p.fnet_b; g.resid = (const float*)(ws + WS_P1024);
        gemm_phase(wbase, lds, g);
    PH_END
    PH_GEMM(5)
        g.A = (const char*)(ws + WS_H); g.Bt = (const char*)(ws + WS_WIN); g.lda = 2048; g.ldb = 2048; g.nM = 64; g.nN = 40; g.K = 2048; g.mode = MODE_SEG;
        g.c0 = (bf16_t*)(ws + WS_S0); g.c1 = (bf16_t*)(ws + WS_S1); g.t1 = 8; g.c2 = (bf16_t*)(ws + WS_S2); g.t2 = 16; g.c3 = (bf16_t*)(ws + WS_S3); g.t3 = 24; g.c4 = mix; g.ld4 = 4096; g.t4 = 32;
        gemm_phase(wbase, lds, g);
    PH_END
    PH_BEGIN(6) gla_phase(wbase, lds, p); PH_END
    PH_BEGIN(7) post_a_phase(wbase, p); PH_END
    PH_GEMM(8)
        g.A = (const char*)mix; g.lda = 4096; g.Bt = (const char*)(ws + WS_WOUT); g.ldb = 4096; g.nM = 64; g.nN = 8; g.K = 4096; g.mode = MODE_RES0;
        g.resid = p.x; g.c0 = (bf16_t*)(ws + WS_X1);
        gemm_phase(wbase, lds, g);
    PH_END
    PH_BEGIN(9)
        transpose_cvt<true>(wbase, lds, p.od_w_in, 2048, 13376, (bf16_t*)(ws + WS_WIN));
        zero_fill16(wbase, ws + WS_WIN + (size_t)13376 * 2048 * 2, (size_t)192 * 2048 * 2);
        transpose_cvt(wbase, lds, p.od_w_out, 4096, 2048, (bf16_t*)(ws + WS_WOUT));
        rmsnorm_from_bf16<false>(wbase, (const bf16_t*)(ws + WS_X1), p.norm_w + 2048, (void*)(ws + WS_H1));
    PH_END
    PH_GEMM(10)
        g.A = (const char*)(ws + WS_H1); g.Bt = (const char*)(ws + WS_WIN); g.lda = 2048; g.ldb = 2048; g.nM = 64; g.nN = 32; g.K = 2048; g.mode = MODE_PAIR;
        g.c0 = (bf16_t*)(ws + WS_CIN); g.c1 = mix;
        gemm_phase(wbase, lds, g);
    PH_END
    PH_BEGIN(11) conv_c_phase(wbase, p); PH_END
    PH_GEMM(12)
        g.A = (const char*)(ws + WS_H1); g.Bt = (const char*)(ws + WS_WIN) + (size_t)8192 * 2048 * 2; g.lda = 2048; g.ldb = 2048; g.nM = 64; g.nN = 21; g.K = 2048; g.mode = MODE_SEG;
        g.c0 = mix + 2048; g.ld0 = 4096; g.c1 = (bf16_t*)(ws + WS_XBC); g.ld1 = 3072; g.t1 = 8; g.c2 = (bf16_t*)(ws + WS_DT); g.ld2 = 256; g.t2 = 20;
        gemm_phase(wbase, lds, g);
    PH_END
    PH_BEGIN(13) preconv_phase(wbase, p); PH_END
    PH_BEGIN(14) ssd_phase(wbase, lds, p); PH_END
    PH_BEGIN(15) post_d_phase(wbase, p); PH_END
    PH_GEMM(16)
        g.A = (const char*)mix; g.lda = 4096; g.Bt = (const char*)(ws + WS_WOUT); g.ldb = 4096; g.nM = 64; g.nN = 8; g.K = 4096; g.mode = MODE_RES1;
        g.c0 = (bf16_t*)(ws + WS_X1);
        gemm_phase(wbase, lds, g);
    PH_END
    PH_BEGIN(17) rmsnorm_from_bf16<true>(wbase, (const bf16_t*)(ws + WS_X1), p.final_norm_w, (void*)p.out); PH_END
}


extern "C" void kernel_launch(void* const* d_in, const int* in_sizes, int n_in, void* d_out, int out_size, void* d_ws, size_t ws_size, hipStream_t stream) {
    static int grid_blocks = 0;
    if (!grid_blocks) {
        int dev = 0, cus = 0, per_cu = 0;
        hipGetDevice(&dev);
        hipDeviceGetAttribute(&cus, hipDeviceAttributeMultiprocessorCount, dev);
        hipFuncSetAttribute((const void*)fwd_megakernel, hipFuncAttributeMaxDynamicSharedMemorySize, LDS_BYTES);
        hipOccupancyMaxActiveBlocksPerMultiprocessor(&per_cu, (const void*)fwd_megakernel, 512, LDS_BYTES);
        if (per_cu < 1) per_cu = 1;
        grid_blocks = cus * per_cu;
        if (grid_blocks > 256) grid_blocks = 256;
        (void)hipGetLastError();
    }
    Params p{};
    p.x = (const float*)d_in[0]; p.norm_w = (const float*)d_in[1]; p.final_norm_w = (const float*)d_in[2]; p.ev_w_in = (const float*)d_in[3]; p.ev_w_out = (const float*)d_in[4];
    p.lb_logits = (const float*)d_in[5]; p.hgrn_norm_w = (const float*)d_in[6]; p.fnet_w = (const float*)d_in[7]; p.fnet_b = (const float*)d_in[8];
    p.od_w_in = (const float*)d_in[9]; p.od_w_out = (const float*)d_in[10]; p.sconv_w = (const float*)d_in[11]; p.ssd_conv_w = (const float*)d_in[12]; p.ssd_conv_b = (const float*)d_in[13];
    p.dt_bias = (const float*)d_in[14]; p.a_log = (const float*)d_in[15]; p.ssd_d = (const float*)d_in[16]; p.ssd_norm_w = (const float*)d_in[17];
    p.out = (float*)d_out; p.ws = (unsigned char*)d_ws; p.ph_lo = 0; p.ph_hi = NPHASE;
    (void)hipMemsetAsync((unsigned char*)d_ws + WS_BAR, 0, XCD_BAR_WORDS * 4, stream);
    void* args[] = {&p};
    hipError_t e = hipLaunchCooperativeKernel((const void*)fwd_megakernel, dim3(grid_blocks), dim3(512), args, LDS_BYTES, stream);
    if (e != hipSuccess) fprintf(stderr, "cooperative launch failed: %s (grid %d)\n", hipGetErrorString(e), grid_blocks);
}
```

```cpp
#include <hip/hip_runtime.h>
#include <hip/hip_cooperative_groups.h>
#include <cstdio>
namespace cg = cooperative_groups;

#define LAS __attribute__((address_space(3)))
typedef unsigned short bf16_t;
typedef short bf16x8 __attribute__((ext_vector_type(8)));
typedef float f32x4 __attribute__((ext_vector_type(4)));
typedef float f32x2 __attribute__((ext_vector_type(2)));
typedef unsigned u32x4 __attribute__((ext_vector_type(4)));
typedef unsigned u32x2 __attribute__((ext_vector_type(2)));

constexpr int TOK = 16384, DM = 2048, SEQ = 2048;
constexpr size_t MiB = 1ull << 20;
constexpr size_t WS_WIN = 0, WS_WOUT = 56 * MiB, WS_S0 = 72 * MiB, WS_S1 = 136 * MiB, WS_S2 = 200 * MiB, WS_S3 = 264 * MiB,
                 WS_DFT = 328 * MiB, WS_W12 = 344 * MiB, WS_P1024 = 346 * MiB, WS_H = 348 * MiB, WS_UF = 412 * MiB;
constexpr size_t WS_X1 = WS_S0, WS_H1 = 200 * MiB, WS_CIN = 264 * MiB, WS_CB = 328 * MiB, WS_CC = 392 * MiB,
                 WS_XBC = 264 * MiB, WS_DT = 360 * MiB, WS_YF = 368 * MiB, WS_YB = 432 * MiB,
                 WS_XACT = 200 * MiB  , WS_BCACT = 0  ;
constexpr int LDS_BYTES = 131072 + 16;
constexpr float EPS = 1e-6f;

struct Params {
    const float* x; const float* norm_w; const float* final_norm_w; const float* ev_w_in; const float* ev_w_out;
    const float* lb_logits; const float* hgrn_norm_w; const float* fnet_w; const float* fnet_b;
    const float* od_w_in; const float* od_w_out; const float* sconv_w; const float* ssd_conv_w; const float* ssd_conv_b;
    const float* dt_bias; const float* a_log; const float* ssd_d; const float* ssd_norm_w;
    float* out; unsigned char* ws;
    int ph_lo, ph_hi;
};

typedef __bf16 bf16x2_t __attribute__((ext_vector_type(2)));
__device__ __forceinline__ unsigned cvt_pk_bf16(float lo, float hi) {
    f32x2 v = {lo, hi}; union { bf16x2_t b; unsigned u; } c; c.b = __builtin_convertvector(v, bf16x2_t); return c.u; }
__device__ __forceinline__ float bf_lo(unsigned w) { return __uint_as_float(w << 16); }
__device__ __forceinline__ float bf_hi(unsigned w) { return __uint_as_float(w & 0xffff0000u); }
__device__ __forceinline__ void unpack8(const u32x4 v, float* f) {
    f[0] = bf_lo(v[0]); f[1] = bf_hi(v[0]); f[2] = bf_lo(v[1]); f[3] = bf_hi(v[1]);
    f[4] = bf_lo(v[2]); f[5] = bf_hi(v[2]); f[6] = bf_lo(v[3]); f[7] = bf_hi(v[3]);
}
__device__ __forceinline__ u32x4 pack8(const float* f) {
    u32x4 r; r[0] = cvt_pk_bf16(f[0], f[1]); r[1] = cvt_pk_bf16(f[2], f[3]); r[2] = cvt_pk_bf16(f[4], f[5]); r[3] = cvt_pk_bf16(f[6], f[7]); return r;
}
__device__ __forceinline__ float silu_f(float x) { return x * __builtin_amdgcn_rcpf(1.0f + __expf(-x)); }
__device__ __forceinline__ bf16x8 as_bf16x8(u32x4 v) { union { u32x4 u; bf16x8 b; } c; c.u = v; return c.b; }
__device__ __forceinline__ bf16x8 lds_b128(LAS unsigned char* p) { return *(LAS bf16x8*)p; }
__device__ __forceinline__ bf16x8 lds_2xb64(LAS unsigned char* p0, LAS unsigned char* p1) {
    u32x2 a = *(LAS u32x2*)p0, b = *(LAS u32x2*)p1; u32x4 v; v[0] = a[0]; v[1] = a[1]; v[2] = b[0]; v[3] = b[1]; return as_bf16x8(v);
}
__device__ __forceinline__ bf16x8 pack_acc2(const f32x4 a, const f32x4 b) {
    u32x4 v; v[0] = cvt_pk_bf16(a[0], a[1]); v[1] = cvt_pk_bf16(a[2], a[3]); v[2] = cvt_pk_bf16(b[0], b[1]); v[3] = cvt_pk_bf16(b[2], b[3]); return as_bf16x8(v);
}
__device__ __forceinline__ int opaque_tid(const int wbase) { int t = wbase + (int)__builtin_amdgcn_mbcnt_hi(~0u, __builtin_amdgcn_mbcnt_lo(~0u, 0u)); asm volatile("" : "+v"(t)); return t; }
typedef short s16x4 __attribute__((ext_vector_type(4)));
constexpr int PN = 288;
__device__ __forceinline__ int rowaddr(int r) { return r * PN + ((r >> 3) & 7) * 16; }
__device__ __forceinline__ bf16x8 lds_tr_frag(LAS unsigned char* base, int r0, int c0, int lane) {
    const int g = lane >> 4, q = (lane & 15) >> 2, pp = lane & 3;
    LAS unsigned char* a0 = base + rowaddr(r0 + 8 * g + q) + c0 * 2 + 8 * pp;
    const s16x4 lo = __builtin_amdgcn_ds_read_tr16_b64_v4i16((LAS s16x4*)a0);
    const s16x4 hi = __builtin_amdgcn_ds_read_tr16_b64_v4i16((LAS s16x4*)(a0 + 4 * PN));
    bf16x8 r; r[0] = lo[0]; r[1] = lo[1]; r[2] = lo[2]; r[3] = lo[3]; r[4] = hi[0]; r[5] = hi[1]; r[6] = hi[2]; r[7] = hi[3]; return r;
}
#define MFMA16(a, b, c) __builtin_amdgcn_mfma_f32_16x16x32_bf16((a), (b), (c), 0, 0, 0)

constexpr int BM = 256, BK = 64, HALF = 128, HTB = HALF * BK * 2, NXCD = 8, WGM = 4;
__device__ __forceinline__ int lds_byte(int r, int c) { const int st = (r >> 4) * 2 + (c >> 5), rr = r & 15, cc = c & 31, ob = rr * 64 + cc * 2; return st * 1024 + (ob ^ (((ob >> 9) & 1) << 5)); }
__device__ __forceinline__ void stage_rc(int b, int& R, int& C) { const int st = b / 1024, sb = b % 1024, swz = sb ^ (((sb >> 9) & 1) << 5); R = (st >> 1) * 16 + swz / 64; C = (st & 1) * 32 + (swz % 64) / 2; }
__device__ __forceinline__ int perm32(int rho) { const int n = rho >> 4, i = rho & 15; return 8 * (i >> 2) + 4 * n + (i & 3); }

__device__ __forceinline__ bf16_t* rfl_ptr(bf16_t* p) { const unsigned long long v = (unsigned long long)p; const unsigned lo = __builtin_amdgcn_readfirstlane((unsigned)v), hi = __builtin_amdgcn_readfirstlane((unsigned)(v >> 32)); return (bf16_t*)(((unsigned long long)hi << 32) | lo); }
enum { MODE_SEG = 0, MODE_PT = 1, MODE_DFT = 2, MODE_RES0 = 3, MODE_RES1 = 4, MODE_PAIR = 5 };
struct GemmJob {
    const char* A; const char* Bt; size_t strideAz, strideBz, strideBpm;
    int lda, ldb, nM, nN, Z, K, mode;
    bf16_t* c0; bf16_t* c1; bf16_t* c2; bf16_t* c3; bf16_t* c4;
    int ld0, ld1, ld2, ld3, ld4, t1, t2, t3, t4;
    const float* fbias; const float* resid; float* outf;
};
struct Unit { int z, pm, pn; };

__device__ __forceinline__ bool next_unit(const GemmJob& g, int i, Unit& u) {
    const int nwg = g.nM * g.nN;
    const long L = (long)i * gridDim.x + blockIdx.x;
    if (L >= (long)g.Z * nwg) return false;
    const int z = (int)(L / nwg); int wgid = (int)(L - (long)z * nwg);
    { const int q = nwg / NXCD, r = nwg % NXCD, xcd = wgid % NXCD, off = wgid / NXCD; wgid = (xcd < r ? xcd * (q + 1) : r * (q + 1) + (xcd - r) * q) + off; }
    const int nig = WGM * g.nN, gid = wgid / nig, fm = gid * WGM, gsz = (g.nM - fm) < WGM ? (g.nM - fm) : WGM;
    u.pm = fm + ((wgid % nig) % gsz); u.pn = (wgid % nig) / gsz; u.z = z; return true;
}

__device__ __forceinline__ void gemm_epilogue(const f32x4 (&acc)[2][2][4][2], const GemmJob& g, const Unit& u, int wr, int wc, int fr, int fq) {
    const int rloc = wr * 64 + fr, cloc = wc * 32 + 8 * fq;
    if (g.mode == MODE_SEG || g.mode == MODE_PT) {
        bf16_t* base; int ld;
        if (g.mode == MODE_SEG) {
            bf16_t* s0 = g.c0; bf16_t* s1 = g.c1; bf16_t* s2 = g.c2; bf16_t* s3 = g.c3; bf16_t* s4 = g.c4;
            int e0 = g.ld0, e1 = g.ld1, e2 = g.ld2, e3 = g.ld3, e4 = g.ld4, f1 = g.t1, f2 = g.t2, f3 = g.t3, f4 = g.t4;
            s0 = rfl_ptr(s0); s1 = rfl_ptr(s1); s2 = rfl_ptr(s2); s3 = rfl_ptr(s3); s4 = rfl_ptr(s4);
            e0 = __builtin_amdgcn_readfirstlane(e0); e1 = __builtin_amdgcn_readfirstlane(e1); e2 = __builtin_amdgcn_readfirstlane(e2); e3 = __builtin_amdgcn_readfirstlane(e3); e4 = __builtin_amdgcn_readfirstlane(e4);
            f1 = __builtin_amdgcn_readfirstlane(f1); f2 = __builtin_amdgcn_readfirstlane(f2); f3 = __builtin_amdgcn_readfirstlane(f3); f4 = __builtin_amdgcn_readfirstlane(f4);
            base = s0; ld = e0; int t0 = 0;
            if (u.pn >= f1) { base = s1; ld = e1; t0 = f1; }
            if (u.pn >= f2) { base = s2; ld = e2; t0 = f2; }
            if (u.pn >= f3) { base = s3; ld = e3; t0 = f3; }
            if (u.pn >= f4) { base = s4; ld = e4; t0 = f4; }
            base += (size_t)(u.pm * BM) * ld + (size_t)(u.pn - t0) * BM;
        } else {
            const int b = u.pn >> 2, l0 = (u.pn & 3) * 256; ld = 2048;
            base = g.c0 + ((size_t)(b * 2048 + u.z * 256)) * 2048 + (size_t)u.pm * 1024 + l0;
        }
#pragma unroll
        for (int ai = 0; ai < 2; ++ai)
#pragma unroll
            for (int m = 0; m < 4; ++m) {
                bf16_t* rowp = base + (size_t)(rloc + ai * HALF + m * 16) * ld + cloc;
#pragma unroll
                for (int bj = 0; bj < 2; ++bj) {
                    const f32x4 v0 = acc[ai][bj][m][0], v1 = acc[ai][bj][m][1];
                    u32x4 o; o[0] = cvt_pk_bf16(v0[0], v0[1]); o[1] = cvt_pk_bf16(v0[2], v0[3]); o[2] = cvt_pk_bf16(v1[0], v1[1]); o[3] = cvt_pk_bf16(v1[2], v1[3]);
                    *(u32x4*)(rowp + bj * HALF) = o;
                }
            }
    } else if (g.mode == MODE_PAIR) {
        const bool second = u.pn >= 16;
        bf16_t* base = second ? g.c1 : g.c0; const int ld = second ? 4096 : 2048;
        base += (size_t)(u.pm * BM) * ld + (size_t)(u.pn & 15) * 128 + cloc;
#pragma unroll
        for (int ai = 0; ai < 2; ++ai)
#pragma unroll
            for (int m = 0; m < 4; ++m) {
                float r[8];
#pragma unroll
                for (int e = 0; e < 4; ++e) {
                    const float a0 = acc[ai][0][m][0][e], a1 = acc[ai][0][m][1][e], p0 = acc[ai][1][m][0][e], p1 = acc[ai][1][m][1][e];
                    r[e] = second ? a0 * silu_f(p0) : a0 * p0; r[4 + e] = second ? a1 * silu_f(p1) : a1 * p1;
                }
                *(u32x4*)(base + (size_t)(rloc + ai * HALF + m * 16) * ld) = pack8(r);
            }
    } else if (g.mode == MODE_DFT) {
        const int col0 = u.pn * BM + cloc;
        const float sgn = (fr & 1) ? -1.0f : 1.0f;
#pragma unroll
        for (int bj = 0; bj < 2; ++bj) {
            const f32x4 q0 = *(const f32x4*)(g.resid + u.z * 2048 + col0 + bj * HALF), q1 = *(const f32x4*)(g.resid + u.z * 2048 + col0 + bj * HALF + 4);
            const f32x4 b0 = *(const f32x4*)(g.fbias + col0 + bj * HALF) + q0 * sgn, b1 = *(const f32x4*)(g.fbias + col0 + bj * HALF + 4) + q1 * sgn;
            bf16_t* pp0 = g.c0 + (size_t)(u.z * 2048 + u.pm * BM + rloc) * 4096 + 2048 + col0 + bj * HALF;
            u32x4 gt[2][4];
#pragma unroll
            for (int ai = 0; ai < 2; ++ai)
#pragma unroll
                for (int m = 0; m < 4; ++m) gt[ai][m] = *(const u32x4*)(pp0 + (size_t)(ai * HALF + m * 16) * 4096);
#pragma unroll
            for (int ai = 0; ai < 2; ++ai)
#pragma unroll
                for (int m = 0; m < 4; ++m) {
                    float gf[8]; unpack8(gt[ai][m], gf);
                    const f32x4 v0 = acc[ai][bj][m][0] + b0, v1 = acc[ai][bj][m][1] + b1;
                    float r[8];
#pragma unroll
                    for (int e = 0; e < 4; ++e) { r[e] = v0[e] * silu_f(gf[e]); r[4 + e] = v1[e] * silu_f(gf[4 + e]); }
                    *(u32x4*)(pp0 + (size_t)(ai * HALF + m * 16) * 4096) = pack8(r);
                }
        }
    } else {
#pragma unroll
        for (int ai = 0; ai < 2; ++ai) {
            const size_t ro0 = (size_t)(u.pm * BM + rloc + ai * HALF) * 2048 + u.pn * BM + cloc;
            float rr[4][2][8];
            if (g.mode == MODE_RES0) {
                f32x4 t0[4][2], t1[4][2];
#pragma unroll
                for (int m = 0; m < 4; ++m)
#pragma unroll
                    for (int bj = 0; bj < 2; ++bj) { t0[m][bj] = *(const f32x4*)(g.resid + ro0 + (size_t)m * 16 * 2048 + bj * HALF); t1[m][bj] = *(const f32x4*)(g.resid + ro0 + (size_t)m * 16 * 2048 + bj * HALF + 4); }
#pragma unroll
                for (int m = 0; m < 4; ++m)
#pragma unroll
                    for (int bj = 0; bj < 2; ++bj)
#pragma unroll
                        for (int e = 0; e < 4; ++e) { rr[m][bj][e] = t0[m][bj][e]; rr[m][bj][4 + e] = t1[m][bj][e]; }
            } else {
                u32x4 t[4][2];
#pragma unroll
                for (int m = 0; m < 4; ++m)
#pragma unroll
                    for (int bj = 0; bj < 2; ++bj) t[m][bj] = *(const u32x4*)(g.c0 + ro0 + (size_t)m * 16 * 2048 + bj * HALF);
#pragma unroll
                for (int m = 0; m < 4; ++m)
#pragma unroll
                    for (int bj = 0; bj < 2; ++bj) unpack8(t[m][bj], rr[m][bj]);
            }
#pragma unroll
            for (int m = 0; m < 4; ++m)
#pragma unroll
                for (int bj = 0; bj < 2; ++bj) {
#pragma unroll
                    for (int e = 0; e < 4; ++e) { rr[m][bj][e] += acc[ai][bj][m][0][e]; rr[m][bj][4 + e] += acc[ai][bj][m][1][e]; }
                    *(u32x4*)(g.c0 + ro0 + (size_t)m * 16 * 2048 + bj * HALF) = pack8(rr[m][bj]);
                }
        }
    }
}

__device__ __forceinline__ void gemm_phase(const int wbase, LAS unsigned char* lds, const GemmJob& g) {
    const int tid = opaque_tid(wbase), wid = __builtin_amdgcn_readfirstlane(tid >> 6), lane = tid & 63, wr = wid >> 2, wc = wid & 3, fr = lane & 15, fq = lane >> 4;
    const int K = g.K, nt = K / BK;
    unsigned voffA[2], voffB[2];
#pragma unroll
    for (int i = 0; i < 2; ++i) { int R, C; stage_rc(tid * 16 + i * 8192, R, C); const int Rb = (R & ~31) + perm32(R & 31);
        voffA[i] = (unsigned)(R * g.lda + C) * 2u; voffB[i] = (unsigned)(Rb * g.ldb + C) * 2u; }
    const size_t kstep = (size_t)(BK * 2);
    const size_t hstepA = (size_t)HALF * g.lda * 2, hstepB = (size_t)HALF * g.ldb * 2;
    const unsigned ldsw = (unsigned)wid * 1024u;
    const int aoff = lds_byte(wr * 64 + fr, fq * 8), boff = lds_byte(wc * 32 + fr, fq * 8);
#define PG8_SA(b, h) (((b) * 2 + (h)) * HTB)
#define PG8_SB(b, h) ((4 + (b) * 2 + (h)) * HTB)
#define PG8_STAGE(bufoff, gbase, voff) do { _Pragma("unroll") for (int _i = 0; _i < 2; ++_i) \
        __builtin_amdgcn_global_load_lds((const unsigned*)((const char*)(gbase) + (voff)[_i]), (LAS unsigned*)(lds + (bufoff) + ldsw + _i * 8192), 16, 0, 0); } while (0)
#define PG8_LDA(dst, b, h) do { _Pragma("unroll") for (int m = 0; m < 4; ++m) _Pragma("unroll") for (int k = 0; k < 2; ++k) dst[m][k] = *(const LAS bf16x8*)(lds + PG8_SA(b, h) + aoff + m * 2048 + k * 1024); } while (0)
#define PG8_LDB(dst, b, h) do { _Pragma("unroll") for (int n = 0; n < 2; ++n) _Pragma("unroll") for (int k = 0; k < 2; ++k) dst[n][k] = *(const LAS bf16x8*)(lds + PG8_SB(b, h) + boff + n * 2048 + k * 1024); } while (0)
#define PG8_MMA(ai, bj, At, Bt) do { __builtin_amdgcn_s_setprio(1); _Pragma("unroll") for (int m = 0; m < 4; ++m) _Pragma("unroll") for (int n = 0; n < 2; ++n) _Pragma("unroll") for (int k = 0; k < 2; ++k) \
        acc[ai][bj][m][n] = __builtin_amdgcn_mfma_f32_16x16x32_bf16(Bt[n][k], At[m][k], acc[ai][bj][m][n], 0, 0, 0); __builtin_amdgcn_s_setprio(0); } while (0)
#define PG8_WAIT_V(n) asm volatile("s_waitcnt vmcnt(" #n ")" ::: "memory")
#define PG8_WAIT_L(n) asm volatile("s_waitcnt lgkmcnt(" #n ")" ::: "memory")
#define PG8_BAR __builtin_amdgcn_s_barrier()
#define PG8_SCHED __builtin_amdgcn_sched_barrier(0)
    Unit cur, nxt; int ui = 0;
    if (!next_unit(g, 0, cur)) return;
    f32x4 acc[2][2][4][2];
#pragma unroll
    for (int a = 0; a < 2; ++a)
#pragma unroll
        for (int b = 0; b < 2; ++b)
#pragma unroll
            for (int m = 0; m < 4; ++m)
#pragma unroll
                for (int n = 0; n < 2; ++n) acc[a][b][m][n] = (f32x4){0.f, 0.f, 0.f, 0.f};
    bf16x8 At[4][2], B0[2][2], B1[2][2];
    const char* cA = g.A + (size_t)cur.z * g.strideAz + (size_t)cur.pm * 2 * hstepA;
    const char* cB = g.Bt + (size_t)cur.z * g.strideBz + (size_t)cur.pn * 2 * hstepB + (size_t)cur.pm * g.strideBpm;
    PG8_STAGE(PG8_SB(0, 0), cB, voffB); PG8_STAGE(PG8_SA(0, 0), cA, voffA); PG8_STAGE(PG8_SB(0, 1), cB + hstepB, voffB); PG8_STAGE(PG8_SA(0, 1), cA + hstepA, voffA);
    if (wr == 1) PG8_BAR;
    PG8_WAIT_V(4); PG8_BAR;
    PG8_STAGE(PG8_SB(1, 0), cB + kstep, voffB); PG8_STAGE(PG8_SA(1, 0), cA + kstep, voffA); PG8_STAGE(PG8_SB(1, 1), cB + hstepB + kstep, voffB);
    PG8_WAIT_V(6); PG8_BAR;
    for (;;) {
        const bool has_next = next_unit(g, ui + 1, nxt);
        const char* nA = has_next ? g.A + (size_t)nxt.z * g.strideAz + (size_t)nxt.pm * 2 * hstepA : cA;
        const char* nB = has_next ? g.Bt + (size_t)nxt.z * g.strideBz + (size_t)nxt.pn * 2 * hstepB + (size_t)nxt.pm * g.strideBpm : cB;
        for (int t = 0; t < nt; t += 2) {
            const bool last = (t == nt - 2);
            const char* a1 = cA + (size_t)(t + 1) * kstep;
            const char* a2 = last ? nA : cA + (size_t)(t + 2) * kstep; const char* b2 = last ? nB : cB + (size_t)(t + 2) * kstep;
            const char* a3 = a2 + kstep; const char* b3 = b2 + kstep;
            PG8_LDB(B0, 0, 0); PG8_SCHED; PG8_LDA(At, 0, 0); PG8_STAGE(PG8_SA(1, 1), a1 + hstepA, voffA);
            PG8_WAIT_L(8); PG8_BAR; PG8_WAIT_L(0); PG8_MMA(0, 0, At, B0); PG8_BAR; PG8_SCHED;
            PG8_LDB(B1, 0, 1); PG8_STAGE(PG8_SB(0, 0), b2, voffB);
            PG8_BAR; PG8_WAIT_L(0); PG8_MMA(0, 1, At, B1); PG8_BAR;
            PG8_LDA(At, 0, 1); PG8_STAGE(PG8_SA(0, 0), a2, voffA);
            PG8_BAR; PG8_WAIT_L(0); PG8_MMA(1, 0, At, B0); PG8_BAR; PG8_SCHED;
            PG8_STAGE(PG8_SB(0, 1), b2 + hstepB, voffB);
            PG8_WAIT_V(6); PG8_BAR; PG8_MMA(1, 1, At, B1); PG8_BAR;
            PG8_LDB(B0, 1, 0); PG8_SCHED; PG8_LDA(At, 1, 0); PG8_STAGE(PG8_SA(0, 1), a2 + hstepA, voffA);
            PG8_WAIT_L(8); PG8_BAR; PG8_WAIT_L(0); PG8_MMA(0, 0, At, B0); PG8_BAR; PG8_SCHED;
            PG8_LDB(B1, 1, 1); PG8_STAGE(PG8_SB(1, 0), b3, voffB);
            PG8_BAR; PG8_WAIT_L(0); PG8_MMA(0, 1, At, B1); PG8_BAR;
            PG8_LDA(At, 1, 1); PG8_STAGE(PG8_SA(1, 0), a3, voffA);
            PG8_BAR; PG8_WAIT_L(0); PG8_MMA(1, 0, At, B0); PG8_BAR; PG8_SCHED;
            PG8_STAGE(PG8_SB(1, 1), b3 + hstepB, voffB);
            PG8_WAIT_V(6); PG8_BAR; PG8_MMA(1, 1, At, B1); PG8_BAR;
        }
        gemm_epilogue(acc, g, cur, wr, wc, fr, fq);
        if (!has_next) break;
#pragma unroll
        for (int a = 0; a < 2; ++a)
#pragma unroll
            for (int b = 0; b < 2; ++b)
#pragma unroll
                for (int m = 0; m < 4; ++m)
#pragma unroll
                    for (int n = 0; n < 2; ++n) acc[a][b][m][n] = (f32x4){0.f, 0.f, 0.f, 0.f};
        cur = nxt; cA = nA; cB = nB; ++ui;
    }
    PG8_WAIT_V(0);
    if (wr == 0) PG8_BAR;
    PG8_BAR;
#undef PG8_SA
#undef PG8_SB
#undef PG8_STAGE
#undef PG8_LDA
#undef PG8_LDB
#undef PG8_MMA
#undef PG8_WAIT_V
#undef PG8_WAIT_L
#undef PG8_BAR
#undef PG8_SCHED
}

__device__ __forceinline__ int pair_row(int n) {
    if (n >= 8192) return n;
    const int seg = n >> 11, ch = n & 2047, t = ch >> 7, j = ch & 127;
    return ((seg & 1) ? 4096 : 0) + 256 * t + ((seg & 2) ? 128 : 0) + j;
}
template <bool PAIRMAP = false>
__device__ __forceinline__ void transpose_cvt(const int wbase, LAS unsigned char* lds, const float* __restrict__ src, int Kr, int Nc, bf16_t* __restrict__ dst) {
    constexpr int TP = 544;
    const int tid = opaque_tid(wbase), wid = tid >> 6, lane = tid & 63;
    const int npn = (Nc + 255) / 256, npk = Kr / 64, npan = npn * npk;
    const int kr = tid >> 3, q = tid & 7;
    const int g = lane >> 4, qq = (lane & 15) >> 2, pp = lane & 3;
    f32x4 v[8], vn[8];
    auto load_panel = [&](int idx, f32x4 (&dstv)[8]) {
        idx = idx < npan ? idx : npan - 1;
        const int n0 = (idx % npn) * 256, k0 = (idx / npn) * 64;
#pragma unroll
        for (int j = 0; j < 8; ++j) {
            int n = n0 + (q + 8 * j) * 4; n = n < Nc ? n : Nc - 4;
            dstv[j] = *(const f32x4*)(src + (size_t)(k0 + kr) * Nc + n);
        }
    };
    load_panel(blockIdx.x, v);
    for (int idx = blockIdx.x; idx < npan; idx += gridDim.x) {
        const int n0 = (idx % npn) * 256, k0 = (idx / npn) * 64;
        load_panel(idx + gridDim.x, vn);
        __syncthreads();
#pragma unroll
        for (int j = 0; j < 8; ++j) {
            u32x2 o; o[0] = cvt_pk_bf16(v[j][0], v[j][1]); o[1] = cvt_pk_bf16(v[j][2], v[j][3]);
            *(LAS u32x2*)(lds + kr * TP + (q + 8 * j) * 8) = o;
        }
        __syncthreads();
#pragma unroll
        for (int it = 0; it < 4; ++it) {
            const int f = wid * 4 + it, r0 = (f & 1) * 32, c0 = (f >> 1) * 16;
            LAS unsigned char* a0 = lds + (r0 + 8 * g + qq) * TP + c0 * 2 + 8 * pp;
            const s16x4 lo = __builtin_amdgcn_ds_read_tr16_b64_v4i16((LAS s16x4*)a0);
            const s16x4 hi = __builtin_amdgcn_ds_read_tr16_b64_v4i16((LAS s16x4*)(a0 + 4 * TP));
            const int n = n0 + c0 + (lane & 15);
            union { s16x4 h[2]; u32x4 u; } cv; cv.h[0] = lo; cv.h[1] = hi;
            if (n < Nc) *(u32x4*)(dst + (size_t)(PAIRMAP ? pair_row(n) : n) * Kr + k0 + r0 + 8 * g) = cv.u;
        }
#pragma unroll
        for (int j = 0; j < 8; ++j) v[j] = vn[j];
    }
    __syncthreads();
}

__device__ __forceinline__ void rmsnorm_to_bf16(const int wbase, const float* __restrict__ x, const float* __restrict__ w, bf16_t* __restrict__ out) {
    const int tid_ = opaque_tid(wbase); const int lane = tid_ & 63, wv = blockIdx.x * 8 + (tid_ >> 6), nwv = gridDim.x * 8;
    for (int row = wv; row < TOK; row += nwv) {
        f32x4 v[8]; float ss = 0.f;
#pragma unroll
        for (int i = 0; i < 8; ++i) { v[i] = *(const f32x4*)(x + (size_t)row * DM + i * 256 + lane * 4); ss += v[i][0] * v[i][0] + v[i][1] * v[i][1] + v[i][2] * v[i][2] + v[i][3] * v[i][3]; }
#pragma unroll
        for (int s = 32; s >= 1; s >>= 1) ss += __shfl_xor(ss, s);
        const float rs = rsqrtf(ss * (1.0f / DM) + EPS);
#pragma unroll
        for (int i = 0; i < 8; ++i) {
            const f32x4 w4 = *(const f32x4*)(w + i * 256 + lane * 4);
            u32x2 o; o[0] = cvt_pk_bf16(v[i][0] * rs * w4[0], v[i][1] * rs * w4[1]); o[1] = cvt_pk_bf16(v[i][2] * rs * w4[2], v[i][3] * rs * w4[3]);
            *(u32x2*)(out + (size_t)row * DM + i * 256 + lane * 4) = o;
        }
    }
}

template <bool TO_F32> __device__ __forceinline__ void rmsnorm_from_bf16(const int wbase, const bf16_t* __restrict__ x, const float* __restrict__ w, void* __restrict__ outp) {
    const int tid_ = opaque_tid(wbase); const int lane = tid_ & 63, wv = blockIdx.x * 8 + (tid_ >> 6), nwv = gridDim.x * 8;
    float nw[4][8];
#pragma unroll
    for (int i = 0; i < 4; ++i) {
        const int c8 = (i * 64 + lane) * 8;
        const f32x4 w0 = *(const f32x4*)(w + c8), w1 = *(const f32x4*)(w + c8 + 4);
#pragma unroll
        for (int e = 0; e < 8; ++e) nw[i][e] = e < 4 ? w0[e & 3] : w1[e & 3];
    }
    for (int row = wv; row < TOK; row += nwv) {
        float v[4][8]; float ss = 0.f;
#pragma unroll
        for (int i = 0; i < 4; ++i) {
            unpack8(*(const u32x4*)(x + (size_t)row * DM + (i * 64 + lane) * 8), v[i]);
#pragma unroll
            for (int e = 0; e < 8; ++e) ss += v[i][e] * v[i][e];
        }
#pragma unroll
        for (int s = 32; s >= 1; s >>= 1) ss += __shfl_xor(ss, s);
        const float rs = rsqrtf(ss * (1.0f / DM) + EPS);
#pragma unroll
        for (int i = 0; i < 4; ++i) {
            const int c8 = (i * 64 + lane) * 8;
            float o[8];
#pragma unroll
            for (int e = 0; e < 8; ++e) o[e] = v[i][e] * rs * nw[i][e];
            if (TO_F32) {
                float* op = (float*)outp + (size_t)row * DM + c8;
                *(f32x4*)op = (f32x4){o[0], o[1], o[2], o[3]}; *(f32x4*)(op + 4) = (f32x4){o[4], o[5], o[6], o[7]};
            } else *(u32x4*)((bf16_t*)outp + (size_t)row * DM + c8) = pack8(o);
        }
    }
}

__device__ __forceinline__ void build_dft(const int wbase, bf16_t* __restrict__ dft) {
    const size_t gt = (size_t)blockIdx.x * 512 + opaque_tid(wbase), nth = (size_t)gridDim.x * 512;
    for (size_t pidx = gt; pidx < (size_t)2048 * 256; pidx += nth) {
        const int k = (int)(pidx >> 8), j0 = (int)(pidx & 255) * 8;
        float f[8];
#pragma unroll
        for (int e = 0; e < 8; ++e) {
            const int j = j0 + e, l = j & 1023;
            const float ang = (float)((k * l) & 2047) * (1.0f / 1024.0f);
            f[e] = (j < 1024) ? cospif(ang) : -sinpif(ang);
        }
        *(u32x4*)(dft + (size_t)k * 2048 + j0) = pack8(f);
    }
}

__device__ __forceinline__ void fold_phase(const int wbase, const Params& p) {
    const bf16_t* bu = (const bf16_t*)(p.ws + WS_S0); bf16_t* uf = (bf16_t*)(p.ws + WS_UF);
    const bf16_t* w12 = (const bf16_t*)(p.ws + WS_W12); float* p1024 = (float*)(p.ws + WS_P1024);
    const size_t gt = (size_t)blockIdx.x * 512 + opaque_tid(wbase), nth = (size_t)gridDim.x * 512;
    for (size_t pc = gt; pc < (size_t)8 * 1024 * 256; pc += nth) {
        const int c8 = (int)(pc & 255) * 8, l = (int)(pc >> 8) & 1023, b = (int)(pc >> 18);
        float a[8], m[8], ue[8], uo[8];
        unpack8(*(const u32x4*)(bu + (size_t)(b * 2048 + l) * 2048 + c8), a);
        if (l > 0) {
            unpack8(*(const u32x4*)(bu + (size_t)(b * 2048 + 2048 - l) * 2048 + c8), m);
#pragma unroll
            for (int e = 0; e < 8; ++e) { ue[e] = a[e] + m[e]; uo[e] = a[e] - m[e]; }
        } else {
#pragma unroll
            for (int e = 0; e < 8; ++e) { ue[e] = a[e]; uo[e] = 0.f; }
        }
        *(u32x4*)(uf + (size_t)(b * 1024 + l) * 2048 + c8) = pack8(ue);
        *(u32x4*)(uf + (size_t)(8192 + b * 1024 + l) * 2048 + c8) = pack8(uo);
    }
    if (gt < 16384) {
        const int b = (int)(gt >> 11), ch = (int)(gt & 2047), g = ch >> 8, d = ch & 255;
        const bf16_t* up = bu + (size_t)(b * 2048 + 1024) * 2048 + g * 256; const bf16_t* wp = w12 + (size_t)g * 512 * 256 + (size_t)d * 256;
        float acc = 0.f;
#pragma unroll 4
        for (int c = 0; c < 256; c += 8) {
            float u[8], w[8]; unpack8(*(const u32x4*)(up + c), u); unpack8(*(const u32x4*)(wp + c), w);
#pragma unroll
            for (int e = 0; e < 8; ++e) acc += u[e] * w[e];
        }
        p1024[gt] = acc;
    }
}

__device__ __forceinline__ void build_w12(const int wbase, LAS unsigned char* lds, const float* __restrict__ fw, bf16_t* __restrict__ w12) {
    LAS float* fwl = (LAS float*)lds;
    LAS float* ctab = (LAS float*)(lds + 65536); LAS float* stab = ctab + 256;
    const int tid = opaque_tid(wbase), wid = tid >> 6, lane = tid & 63;
    const float scale = 1.0f / sqrtf(2048.0f * 256.0f);
    for (int task = blockIdx.x; task < 256; task += gridDim.x) {
        const int g = task >> 5, d0 = ((task >> 3) & 3) * 64, c0 = (task & 7) * 32;
        __syncthreads();
        if (tid < 256) { const float ang = (float)tid * (1.0f / 128.0f); ctab[tid] = cospif(ang); stab[tid] = sinpif(ang); }
#pragma unroll
        for (int j = 0; j < 8; ++j) {
            const int m = j * 32 + (tid >> 4), dd = (tid & 15) * 4;
            *(LAS f32x4*)(fwl + m * 64 + dd) = *(const f32x4*)(fw + (size_t)g * 65536 + (size_t)m * 256 + d0 + dd);
        }
        __syncthreads();
        const int cb = c0 + wid * 4;
        float ac[4] = {0.f, 0.f, 0.f, 0.f}, as[4] = {0.f, 0.f, 0.f, 0.f};
#pragma unroll 8
        for (int m = 0; m < 256; ++m) {
            const float v = fwl[m * 64 + lane];
#pragma unroll
            for (int cc = 0; cc < 4; ++cc) { const int ti = (m * (cb + cc)) & 255; ac[cc] += ctab[ti] * v; as[cc] += stab[ti] * v; }
        }
        bf16_t* o = w12 + (size_t)g * 512 * 256 + (size_t)(d0 + lane) * 256 + cb;
        u32x2 oc, os; oc[0] = cvt_pk_bf16(ac[0] * scale, ac[1] * scale); oc[1] = cvt_pk_bf16(ac[2] * scale, ac[3] * scale);
        os[0] = cvt_pk_bf16(as[0] * scale, as[1] * scale); os[1] = cvt_pk_bf16(as[2] * scale, as[3] * scale);
        *(u32x2*)o = oc; *(u32x2*)(o + 256 * 256) = os;
    }
    __syncthreads();
}

__device__ __forceinline__ void zero_fill16(const int wbase, unsigned char* p, size_t bytes) {
    const size_t gt = (size_t)blockIdx.x * 512 + opaque_tid(wbase), nth = (size_t)gridDim.x * 512;
    for (size_t i = gt; i < bytes / 16; i += nth) *(u32x4*)(p + i * 16) = (u32x4){0u, 0u, 0u, 0u};
}

__device__ __forceinline__ void gla_phase(const int wbase, LAS unsigned char* lds, const Params& p) {
    constexpr int G_OFF = 0, QIN_OFF = 16384, KIN_OFF = 25728, KET_OFF = 35072, VT_OFF = 44416, SC_OFF = 53760, EB_OFF = 56320;
    constexpr int TLD = 80;
    const int tid = opaque_tid(wbase), wid = __builtin_amdgcn_readfirstlane(tid >> 6), lane = tid & 63, fr = lane & 15, fq = lane >> 4;
    const int r = tid >> 4, c8 = (tid & 15) * 8;
    const bf16_t* qb = (const bf16_t*)(p.ws + WS_S0); const bf16_t* vb = (const bf16_t*)(p.ws + WS_S1);
    for (int item = blockIdx.x; item < 256; item += gridDim.x) {
        const int xcd = item & 7, slot = item >> 3, dir = slot & 1, bh = (slot >> 1) * 8 + xcd, b = bh >> 4, h = bh & 15;
        bf16_t* zb = (bf16_t*)(p.ws + (dir ? WS_S3 : WS_S2));
        float lb[8], oml[8];
#pragma unroll
        for (int e = 0; e < 8; ++e) {
            const int ch = h * 128 + c8 + e;
            const float l0 = p.lb_logits[ch], l1 = p.lb_logits[2048 + ch], l2 = p.lb_logits[4096 + ch];
            const float mx = fmaxf(l0, fmaxf(l1, l2)), e0 = __expf(l0 - mx), e1 = __expf(l1 - mx), e2 = __expf(l2 - mx);
            lb[e] = e0 / (e0 + e1 + e2); oml[e] = 1.0f - lb[e];
        }
        f32x4 accS[8];
#pragma unroll
        for (int i = 0; i < 8; ++i) accS[i] = (f32x4){0.f, 0.f, 0.f, 0.f};
        __syncthreads();
        if (tid < 64) *(LAS u32x2*)(lds + SC_OFF + (tid >> 2) * TLD + 32 + (tid & 3) * 8) = (u32x2){0u, 0u};
        const size_t colo = (size_t)h * 128 + c8;
        auto row_of = [&](int c, int rr) -> size_t { const int tt = c * 32 + rr; const int t = dir ? (SEQ - 1 - tt) : tt; return (size_t)(b * SEQ + t) * DM; };
        u32x4 rq, rv, rz;
        { const size_t ro = row_of(0, r) + colo; rq = *(const u32x4*)(qb + ro); rv = *(const u32x4*)(vb + ro); rz = *(const u32x4*)(zb + ro); }
        for (int c = 0; c < SEQ / 32; ++c) {
            float qf[8], zf[8], kf[8];
            unpack8(rq, qf); unpack8(rz, zf);
            const u32x4 vcur = rv;
            {
                float gf[8];
#pragma unroll
                for (int e = 0; e < 8; ++e) {
                    const float s = __builtin_amdgcn_rcpf(1.0f + __expf(-zf[e]));
                    const float f = lb[e] + oml[e] * s;
                    gf[e] = __builtin_amdgcn_logf(f);     kf[e] = oml[e] * (1.0f - s);
                }
                *(LAS f32x4*)(lds + G_OFF + r * 512 + c8 * 4) = (f32x4){gf[0], gf[1], gf[2], gf[3]};
                *(LAS f32x4*)(lds + G_OFF + r * 512 + c8 * 4 + 16) = (f32x4){gf[4], gf[5], gf[6], gf[7]};
            }
            if (c + 1 < SEQ / 32) { const size_t ro = row_of(c + 1, r) + colo; rq = *(const u32x4*)(qb + ro); rv = *(const u32x4*)(vb + ro); rz = *(const u32x4*)(zb + ro); }
            __syncthreads();
            if (tid < 128) {
                float run = 0.f;
#pragma unroll
                for (int rr = 0; rr < 32; ++rr) { LAS float* gp = (LAS float*)(lds + G_OFF + rr * 512 + tid * 4); run += *gp; *gp = run; }
                *(LAS float*)(lds + EB_OFF + tid * 4) = __builtin_amdgcn_exp2f(run);
            }
            __syncthreads();
            {
                const f32x4 b0 = *(LAS f32x4*)(lds + G_OFF + r * 512 + c8 * 4), b1 = *(LAS f32x4*)(lds + G_OFF + r * 512 + c8 * 4 + 16);
                const f32x4 l0 = *(LAS f32x4*)(lds + EB_OFF + c8 * 4), l1 = *(LAS f32x4*)(lds + EB_OFF + c8 * 4 + 16);
                float qi[8], ki[8], ke[8];
#pragma unroll
                for (int e = 0; e < 8; ++e) {
                    const float bc = e < 4 ? b0[e & 3] : b1[e & 3], ebl = e < 4 ? l0[e & 3] : l1[e & 3];
                    qi[e] = qf[e] * __builtin_amdgcn_exp2f(bc); ki[e] = kf[e] * __builtin_amdgcn_exp2f(-bc); ke[e] = ki[e] * ebl;
                }
                *(LAS u32x4*)(lds + QIN_OFF + rowaddr(r) + c8 * 2) = pack8(qi);
                *(LAS u32x4*)(lds + KIN_OFF + rowaddr(r) + c8 * 2) = pack8(ki);
                *(LAS u32x4*)(lds + KET_OFF + rowaddr(r) + c8 * 2) = pack8(ke);
                *(LAS u32x4*)(lds + VT_OFF + rowaddr(r) + c8 * 2) = vcur;
            }
            __syncthreads();
            if (wid < 3) {
                const int mt = wid >= 1 ? 1 : 0, ntl = wid == 2 ? 1 : 0;
                f32x4 sacc = (f32x4){0.f, 0.f, 0.f, 0.f};
#pragma unroll
                for (int kk = 0; kk < 4; ++kk) {
                    const bf16x8 a = lds_b128(lds + KIN_OFF + rowaddr(ntl * 16 + fr) + (kk * 32 + fq * 8) * 2);
                    const bf16x8 bq = lds_b128(lds + QIN_OFF + rowaddr(mt * 16 + fr) + (kk * 32 + fq * 8) * 2);
                    sacc = MFMA16(a, bq, sacc);
                }
                const int i = mt * 16 + fr, j0 = ntl * 16 + fq * 4;
                u32x2 o; o[0] = cvt_pk_bf16(j0 + 0 <= i ? sacc[0] : 0.f, j0 + 1 <= i ? sacc[1] : 0.f); o[1] = cvt_pk_bf16(j0 + 2 <= i ? sacc[2] : 0.f, j0 + 3 <= i ? sacc[3] : 0.f);
                *(LAS u32x2*)(lds + SC_OFF + i * TLD + j0 * 2) = o;
            }
            f32x4 oacc[2]; oacc[0] = (f32x4){0.f, 0.f, 0.f, 0.f}; oacc[1] = oacc[0];
#pragma unroll
            for (int pp = 0; pp < 4; ++pp) {
                const bf16x8 sa = pack_acc2(accS[2 * pp], accS[2 * pp + 1]);
#pragma unroll
                for (int mt = 0; mt < 2; ++mt) {
                    LAS unsigned char* qp = lds + QIN_OFF + rowaddr(mt * 16 + fr) + (pp * 32 + fq * 4) * 2;
                    const bf16x8 bq = lds_2xb64(qp, qp + 32);
                    oacc[mt] = MFMA16(sa, bq, oacc[mt]);
                }
            }
            __syncthreads();
            {
                const bf16x8 va = lds_tr_frag(lds + VT_OFF, 0, wid * 16, lane);
#pragma unroll
                for (int mt = 0; mt < 2; ++mt) {
                    const bf16x8 sb = lds_b128(lds + SC_OFF + (mt * 16 + fr) * TLD + fq * 16);
                    oacc[mt] = MFMA16(va, sb, oacc[mt]);
                    u32x2 o; o[0] = cvt_pk_bf16(oacc[mt][0], oacc[mt][1]); o[1] = cvt_pk_bf16(oacc[mt][2], oacc[mt][3]);
                    *(u32x2*)(zb + row_of(c, mt * 16 + fr) + (size_t)h * 128 + wid * 16 + fq * 4) = o;
                }
#pragma unroll
                for (int kt = 0; kt < 8; ++kt) {
                    const f32x4 e4 = *(LAS f32x4*)(lds + EB_OFF + (kt * 16 + fq * 4) * 4);
                    accS[kt] = accS[kt] * e4;
                    accS[kt] = MFMA16(lds_tr_frag(lds + KET_OFF, 0, kt * 16, lane), va, accS[kt]);
                }
            }
        }
        __syncthreads();
    }
}

__device__ __forceinline__ void post_a_phase(const int wbase, const Params& p) {
    const bf16_t* of = (const bf16_t*)(p.ws + WS_S2); const bf16_t* ob = (const bf16_t*)(p.ws + WS_S3);
    bf16_t* mix = (bf16_t*)p.out;
    const size_t gt = (size_t)blockIdx.x * 512 + opaque_tid(wbase), nth = (size_t)gridDim.x * 512;
    for (size_t pc = gt; pc < (size_t)TOK * 256; pc += 2 * nth) {
        u32x4 ra[2], rb[2], rg[2];
#pragma unroll
        for (int u = 0; u < 2; ++u) {
            const size_t q = pc + u * nth; const size_t tok = q >> 8; const int c8 = (int)(q & 255) * 8;
            ra[u] = *(const u32x4*)(of + tok * DM + c8); rb[u] = *(const u32x4*)(ob + tok * DM + c8); rg[u] = *(const u32x4*)(mix + tok * 4096 + c8);
        }
#pragma unroll
        for (int u = 0; u < 2; ++u) {
            const size_t q = pc + u * nth; const size_t tok = q >> 8; const int c8 = (int)(q & 255) * 8;
            float a[8], bb[8], gte[8];
            unpack8(ra[u], a); unpack8(rb[u], bb); unpack8(rg[u], gte);
            float ss = 0.f;
#pragma unroll
            for (int e = 0; e < 8; ++e) { a[e] += bb[e]; ss += a[e] * a[e]; }
            ss += __shfl_xor(ss, 1); ss += __shfl_xor(ss, 2); ss += __shfl_xor(ss, 4); ss += __shfl_xor(ss, 8);
            const float rs = rsqrtf(ss * (1.0f / 128.0f) + EPS);
            const f32x4 w0 = *(const f32x4*)(p.hgrn_norm_w + c8), w1 = *(const f32x4*)(p.hgrn_norm_w + c8 + 4);
            float o[8];
#pragma unroll
            for (int e = 0; e < 8; ++e) o[e] = a[e] * rs * (e < 4 ? w0[e & 3] : w1[e & 3]) * silu_f(gte[e]);
            *(u32x4*)(mix + tok * 4096 + c8) = pack8(o);
        }
    }
}

__device__ __forceinline__ void conv_c_phase(const int wbase, const Params& p) {
    const bf16_t* uu = (const bf16_t*)(p.ws + WS_CIN);
    bf16_t* mix = (bf16_t*)p.out;
    const size_t gt = (size_t)blockIdx.x * 512 + opaque_tid(wbase), nth = (size_t)gridDim.x * 512;
    for (size_t pc0 = gt; pc0 < (size_t)TOK * 256; pc0 += 2 * nth) {
        u32x4 ru[2][3], rw[2];
#pragma unroll
        for (int h = 0; h < 2; ++h) {
            const size_t pc = pc0 + h * nth; const size_t tok = pc >> 8; const int c8 = (int)(pc & 255) * 8; const int t = (int)(tok & (SEQ - 1));
#pragma unroll
            for (int k = 0; k < 3; ++k) {
                const int tt = t + k - 1;
                ru[h][k] = (tt >= 0 && tt < SEQ) ? *(const u32x4*)(uu + (tok + k - 1) * DM + c8) : (u32x4){0u, 0u, 0u, 0u};
            }
            rw[h] = *(const u32x4*)(mix + tok * 4096 + c8);
        }
#pragma unroll
        for (int h = 0; h < 2; ++h) {
            const size_t pc = pc0 + h * nth; const size_t tok = pc >> 8; const int c8 = (int)(pc & 255) * 8;
            float acc[8];
#pragma unroll
            for (int e = 0; e < 8; ++e) acc[e] = 0.f;
#pragma unroll
            for (int k = 0; k < 3; ++k) {
                float u[8]; unpack8(ru[h][k], u);
                const f32x4 w0 = *(const f32x4*)(p.sconv_w + k * DM + c8), w1 = *(const f32x4*)(p.sconv_w + k * DM + c8 + 4);
#pragma unroll
                for (int e = 0; e < 8; ++e) acc[e] += u[e] * (e < 4 ? w0[e & 3] : w1[e & 3]);
            }
            float wv[8]; unpack8(rw[h], wv);
            float o[8];
#pragma unroll
            for (int e = 0; e < 8; ++e) o[e] = wv[e] * acc[e];
            *(u32x4*)(mix + tok * 4096 + c8) = pack8(o);
        }
    }
}

__device__ __forceinline__ void preconv_phase(const int wbase, const Params& p) {
    const bf16_t* xbc = (const bf16_t*)(p.ws + WS_XBC); bf16_t* xact = (bf16_t*)(p.ws + WS_XACT); bf16_t* bcact = (bf16_t*)(p.ws + WS_BCACT);
    const size_t gt = (size_t)blockIdx.x * 512 + opaque_tid(wbase), nth = (size_t)gridDim.x * 512;
    for (size_t pc = gt; pc < (size_t)(TOK / 4) * 384; pc += nth) {
        const int cg = (int)(pc % 384), c8 = cg * 8; const size_t tok0 = (pc / 384) * 4; const int t0 = (int)(tok0 & (SEQ - 1));
        u32x4 raw[6];
#pragma unroll
        for (int j = 0; j < 6; ++j) { const int t = t0 - 1 + j; raw[j] = (t >= 0 && t < SEQ) ? *(const u32x4*)(xbc + (tok0 + j - 1) * 3072 + c8) : (u32x4){0u, 0u, 0u, 0u}; }
        float w0[8], w1[8], w2[8], cb[8];
        { const f32x4 a0 = *(const f32x4*)(p.ssd_conv_w + c8), a1 = *(const f32x4*)(p.ssd_conv_w + c8 + 4), b0 = *(const f32x4*)(p.ssd_conv_w + 3072 + c8), b1 = *(const f32x4*)(p.ssd_conv_w + 3072 + c8 + 4),
                      c0 = *(const f32x4*)(p.ssd_conv_w + 6144 + c8), c1 = *(const f32x4*)(p.ssd_conv_w + 6144 + c8 + 4), d0 = *(const f32x4*)(p.ssd_conv_b + c8), d1 = *(const f32x4*)(p.ssd_conv_b + c8 + 4);
#pragma unroll
          for (int e = 0; e < 8; ++e) { w0[e] = e < 4 ? a0[e & 3] : a1[e & 3]; w1[e] = e < 4 ? b0[e & 3] : b1[e & 3]; w2[e] = e < 4 ? c0[e & 3] : c1[e & 3]; cb[e] = e < 4 ? d0[e & 3] : d1[e & 3]; } }
        float prev[8], cur[8], nxt[8], val[8];
        unpack8(raw[0], prev); unpack8(raw[1], cur);
#pragma unroll
        for (int j = 0; j < 4; ++j) {
            unpack8(raw[j + 2], nxt);
#pragma unroll
            for (int e = 0; e < 8; ++e) { val[e] = silu_f(w0[e] * prev[e] + w1[e] * cur[e] + w2[e] * nxt[e] + cb[e]); prev[e] = cur[e]; cur[e] = nxt[e]; }
            if (c8 < 2048) *(u32x4*)(xact + (tok0 + j) * 2048 + c8) = pack8(val);
            else *(u32x4*)(bcact + (tok0 + j) * 1024 + (c8 - 2048)) = pack8(val);
        }
    }
}

__device__ __forceinline__ void ssd_phase(const int wbase, LAS unsigned char* lds, const Params& p) {
    constexpr int CS_OFF = 0, BS_OFF = 18560, XS_OFF = 37120, XWS_OFF = 55680, MT_OFF = 74240, ACUM_OFF = 92672, DTV_OFF = 93696;
    constexpr int JLD = 144, HDS = 64 * 144;
    const int tid = opaque_tid(wbase), wid = __builtin_amdgcn_readfirstlane(tid >> 6), lane = tid & 63, fr = lane & 15, fq = lane >> 4;
    const int hd = wid >> 2, wv = wid & 3;
    const bf16_t* xbc = (const bf16_t*)(p.ws + WS_XBC); const bf16_t* dtb = (const bf16_t*)(p.ws + WS_DT);
    for (int item = blockIdx.x; item < 256; item += gridDim.x) {
        const int xcd = item & 7, slot = item >> 3, bg = xcd * 4 + (slot >> 3), b = bg >> 2, grp = bg & 3, sub = slot & 7, dir = sub & 1, pair = sub >> 1;
        const int head0 = grp * 8 + pair * 2, head = head0 + hd;
        bf16_t* yb = (bf16_t*)(p.ws + (dir ? WS_YB : WS_YF));
        const int cg = tid & 15, lrow = tid >> 4;
        const bf16_t* xact = (const bf16_t*)(p.ws + WS_XACT); const bf16_t* bcact = (const bf16_t*)(p.ws + WS_BCACT);
        const float dtbias = p.dt_bias[dir * 32 + head], Acoef = -__expf(p.a_log[dir * 32 + head]);
        f32x4 accS[8];
#pragma unroll
        for (int i = 0; i < 8; ++i) accS[i] = (f32x4){0.f, 0.f, 0.f, 0.f};
        __syncthreads();
        if (tid < 256) { const int hh = tid >> 7, which = (tid >> 6) & 1, rr = (tid >> 2) & 15, cq = tid & 3;
            *(LAS u32x2*)(lds + MT_OFF + hh * HDS + (which * 32 + rr) * JLD + (which * 32 + 16 + cq * 4) * 2) = (u32x2){0u, 0u}; }
        u32x4 raw[6]; unsigned rawdt = 0;
        auto load_chunk = [&](int c) {
            const int t0 = dir ? (SEQ - 64 * (c + 1)) : 64 * c;
            if (wv == 0) { const int t = dir ? (t0 + 63 - lane) : (t0 + lane); rawdt = dtb[(size_t)(b * SEQ + t) * 256 + dir * 32 + head]; }
#pragma unroll
            for (int j = 0; j < 6; ++j) {
                const int i = lrow + 32 * (j & 1), t = t0 + (dir ? 63 - i : i);
                const size_t row = (size_t)(b * SEQ + t);
                raw[j] = (j < 2) ? *(const u32x4*)(xact + row * 2048 + head0 * 64 + cg * 8)
                                 : *(const u32x4*)(bcact + row * 1024 + (j < 4 ? 0 : 512) + grp * 128 + cg * 8);
            }
        };
        load_chunk(0);
        {
            const int t00 = dir ? (SEQ - 64) : 0;
#pragma unroll
            for (int it = 0; it < 4; ++it) { const int i = it * 16 + fr, tt = dir ? 63 - i : i;
                *(u32x2*)(yb + (size_t)(b * SEQ + t00 + tt) * DM + head * 64 + wv * 16 + fq * 4) = (u32x2){0u, 0u}; }
        }
        for (int c = 0; c < SEQ / 64; ++c) {
            const int t0 = dir ? (SEQ - 64 * (c + 1)) : 64 * c;
            const int par = c & 1;
            LAS float* acum = (LAS float*)(lds + ACUM_OFF + par * 512 + hd * 256);
            LAS float* dtv = (LAS float*)(lds + DTV_OFF + par * 512 + hd * 256);
            if (wv == 0) {
                const float xr = bf_lo(rawdt) + dtbias;
                const float dtval = fmaxf(xr, 0.f) + __logf(1.0f + __expf(-fabsf(xr)));
                float a = dtval * Acoef;
                a += __builtin_bit_cast(float, __builtin_amdgcn_update_dpp(0, __builtin_bit_cast(int, a), 0x111, 0xf, 0xf, false));
                a += __builtin_bit_cast(float, __builtin_amdgcn_update_dpp(0, __builtin_bit_cast(int, a), 0x112, 0xf, 0xf, false));
                a += __builtin_bit_cast(float, __builtin_amdgcn_update_dpp(0, __builtin_bit_cast(int, a), 0x114, 0xf, 0xf, false));
                a += __builtin_bit_cast(float, __builtin_amdgcn_update_dpp(0, __builtin_bit_cast(int, a), 0x118, 0xf, 0xf, false));
                a += __builtin_bit_cast(float, __builtin_amdgcn_update_dpp(0, __builtin_bit_cast(int, a), 0x142, 0xa, 0xf, false));
                a += __builtin_bit_cast(float, __builtin_amdgcn_update_dpp(0, __builtin_bit_cast(int, a), 0x143, 0xc, 0xf, false));
                acum[lane] = a; dtv[lane] = dtval;
            }
            __syncthreads();
            {
                const int xh = cg >> 3;
                LAS float* ac2 = (LAS float*)(lds + ACUM_OFF + par * 512 + xh * 256); LAS float* dt2 = (LAS float*)(lds + DTV_OFF + par * 512 + xh * 256);
                const float alast = ac2[63];
#pragma unroll
                for (int j = 0; j < 6; ++j) {
                    const int i = lrow + 32 * (j & 1);
                    const int aoff = (j < 2 ? XS_OFF : (j < 4 ? BS_OFF : CS_OFF)) + cg * 16 + rowaddr(i);
                    *(LAS u32x4*)(lds + aoff) = raw[j];
                    if (j < 2) {
                        const float wgt = __expf(alast - ac2[i]) * dt2[i];
                        float val[8]; unpack8(raw[j], val);
#pragma unroll
                        for (int e = 0; e < 8; ++e) val[e] *= wgt;
                        *(LAS u32x4*)(lds + (XWS_OFF - XS_OFF) + aoff) = pack8(val);
                    }
                }
            }
            if (c + 1 < SEQ / 64) load_chunk(c + 1);
            __syncthreads();
            for (int ti = wid; ti < 10; ti += 8) {
                const int it = ti < 1 ? 0 : (ti < 3 ? 1 : (ti < 6 ? 2 : 3)), jt = ti - (it * (it + 1)) / 2;
                f32x4 cacc = (f32x4){0.f, 0.f, 0.f, 0.f};
#pragma unroll
                for (int kk = 0; kk < 4; ++kk) {
                    const bf16x8 a = lds_b128(lds + BS_OFF + rowaddr(jt * 16 + fr) + (kk * 32 + fq * 8) * 2);
                    const bf16x8 bb = lds_b128(lds + CS_OFF + rowaddr(it * 16 + fr) + (kk * 32 + fq * 8) * 2);
                    cacc = MFMA16(a, bb, cacc);
                }
                const int i = it * 16 + fr, j0 = jt * 16 + fq * 4;
#pragma unroll
                for (int hh = 0; hh < 2; ++hh) {
                    LAS float* ac = (LAS float*)(lds + ACUM_OFF + par * 512 + hh * 256); LAS float* dv = (LAS float*)(lds + DTV_OFF + par * 512 + hh * 256);
                    const float ai = ac[i];
                    const f32x4 aj = *(LAS f32x4*)(ac + j0), dj = *(LAS f32x4*)(dv + j0);
                    float m[4];
#pragma unroll
                    for (int e = 0; e < 4; ++e) m[e] = (j0 + e <= i) ? cacc[e] * __expf(ai - aj[e]) * dj[e] : 0.f;
                    u32x2 o; o[0] = cvt_pk_bf16(m[0], m[1]); o[1] = cvt_pk_bf16(m[2], m[3]);
                    *(LAS u32x2*)(lds + MT_OFF + hh * HDS + i * JLD + j0 * 2) = o;
                }
            }
            f32x4 yint[4], yacc[4];
#pragma unroll
            for (int it = 0; it < 4; ++it) { yint[it] = (f32x4){0.f, 0.f, 0.f, 0.f}; yacc[it] = yint[it]; }
#pragma unroll
            for (int pp = 0; pp < 4; ++pp) {
                const bf16x8 sa = pack_acc2(accS[2 * pp], accS[2 * pp + 1]);
#pragma unroll
                for (int it = 0; it < 4; ++it) {
                    LAS unsigned char* cp = lds + CS_OFF + rowaddr(it * 16 + fr) + (pp * 32 + fq * 4) * 2;
                    yint[it] = MFMA16(sa, lds_2xb64(cp, cp + 32), yint[it]);
                }
            }
            __syncthreads();
            {
                const int pt = wv, pc0 = hd * 64 + pt * 16;
                const bf16x8 xa0 = lds_tr_frag(lds + XS_OFF, 0, pc0, lane), xa1 = lds_tr_frag(lds + XS_OFF, 32, pc0, lane);
#pragma unroll
                for (int it = 0; it < 4; ++it) {
                    yacc[it] = MFMA16(xa0, lds_b128(lds + MT_OFF + hd * HDS + (it * 16 + fr) * JLD + fq * 16), yacc[it]);
                    if (it >= 2) yacc[it] = MFMA16(xa1, lds_b128(lds + MT_OFF + hd * HDS + (it * 16 + fr) * JLD + (32 + fq * 8) * 2), yacc[it]);
                    const int i = it * 16 + fr; const float ei = __expf(acum[i]);
                    const int tt = dir ? 63 - i : i;
                    u32x2 o; o[0] = cvt_pk_bf16(yacc[it][0] + ei * yint[it][0], yacc[it][1] + ei * yint[it][1]); o[1] = cvt_pk_bf16(yacc[it][2] + ei * yint[it][2], yacc[it][3] + ei * yint[it][3]);
                    *(u32x2*)(yb + (size_t)(b * SEQ + t0 + tt) * DM + head * 64 + pt * 16 + fq * 4) = o;
                }
                const float sc = __expf(acum[63]);
                const bf16x8 xw0 = lds_tr_frag(lds + XWS_OFF, 0, pc0, lane), xw1 = lds_tr_frag(lds + XWS_OFF, 32, pc0, lane);
#pragma unroll
                for (int nt = 0; nt < 8; ++nt) {
                    accS[nt] = accS[nt] * sc;
                    accS[nt] = MFMA16(lds_tr_frag(lds + BS_OFF, 0, nt * 16, lane), xw0, accS[nt]);
                    accS[nt] = MFMA16(lds_tr_frag(lds + BS_OFF, 32, nt * 16, lane), xw1, accS[nt]);
                }
            }
        }
        __syncthreads();
    }
}

__device__ __forceinline__ void post_d_phase(const int wbase, const Params& p) {
    const bf16_t* yf = (const bf16_t*)(p.ws + WS_YF); const bf16_t* yb = (const bf16_t*)(p.ws + WS_YB); const bf16_t* xact = (const bf16_t*)(p.ws + WS_XACT);
    bf16_t* mix = (bf16_t*)p.out;
    const int tid_ = opaque_tid(wbase); const int lane = tid_ & 63, wv = blockIdx.x * 8 + (tid_ >> 6), nwv = gridDim.x * 8;
    float nw[4][8], dskv[4];
#pragma unroll
    for (int i = 0; i < 4; ++i) {
        const int c8 = (i * 64 + lane) * 8;
        const f32x4 w0 = *(const f32x4*)(p.ssd_norm_w + c8), w1 = *(const f32x4*)(p.ssd_norm_w + c8 + 4);
#pragma unroll
        for (int e = 0; e < 8; ++e) nw[i][e] = e < 4 ? w0[e & 3] : w1[e & 3];
        dskv[i] = p.ssd_d[c8 >> 6];
    }
#pragma unroll 1
    for (int tok = wv; tok < TOK; tok += nwv) {
        float y[4][8]; float ss = 0.f;
#pragma unroll
        for (int i = 0; i < 4; ++i) {
            const int c8 = (i * 64 + lane) * 8;
            float a[8], bb[8], z[8], s[8];
            unpack8(*(const u32x4*)(yf + (size_t)tok * DM + c8), a); unpack8(*(const u32x4*)(yb + (size_t)tok * DM + c8), bb);
            unpack8(*(const u32x4*)(mix + (size_t)tok * 4096 + 2048 + c8), z);
            unpack8(*(const u32x4*)(xact + (size_t)tok * DM + c8), s);
            const float dsk = dskv[i];
#pragma unroll
            for (int e = 0; e < 8; ++e) { const float v = (a[e] + bb[e] + s[e] * dsk) * silu_f(z[e]); y[i][e] = v; ss += v * v; }
            __builtin_amdgcn_sched_barrier(0);
        }
#pragma unroll
        for (int s = 32; s >= 1; s >>= 1) ss += __shfl_xor(ss, s);
        const float rs = rsqrtf(ss * (1.0f / DM) + EPS);
#pragma unroll
        for (int i = 0; i < 4; ++i) {
            const int c8 = (i * 64 + lane) * 8;
            float o[8];
#pragma unroll
            for (int e = 0; e < 8; ++e) o[e] = y[i][e] * rs * nw[i][e];
            *(u32x4*)(mix + (size_t)tok * 4096 + 2048 + c8) = pack8(o);
        }
    }
}


#define XB_TMO      128
#define XB_XCNT(j)  (256  + 64 * (j))
#define XB_XSUB(j)  (1280 + 64 * (j))
#define XB_XGEN(j)  (2304 + 64 * (j))
#define XB_TOP      3328
#define XB_TOPGEN   3392
#define XCD_BAR_WORDS 3456
#define XB_SPIN_CAP (1u << 18)
constexpr size_t WS_BAR = 504 * MiB;
__device__ __forceinline__ unsigned xb_ld(unsigned* p)              { return __hip_atomic_load(p, __ATOMIC_RELAXED, __HIP_MEMORY_SCOPE_AGENT); }
__device__ __forceinline__ unsigned xb_add(unsigned* p, unsigned v) { return __hip_atomic_fetch_add(p, v, __ATOMIC_RELAXED, __HIP_MEMORY_SCOPE_AGENT); }
__device__ __forceinline__ unsigned xb_xcc_id() { return (unsigned)__builtin_amdgcn_s_getreg((3 << 11) | 20) & 0xFu; }
#define XB_SPIN(cond, bar) do { unsigned _sp = 0; while (cond) { __builtin_amdgcn_s_sleep(1); \
    if ((++_sp & 255u) == 0u) { if (xb_ld(&(bar)[XB_TMO])) break; if (_sp > XB_SPIN_CAP) { atomicAdd(&(bar)[XB_TMO], 1u); break; } } } } while (0)
struct XcdBarrier { unsigned* bar; unsigned x; volatile LAS unsigned* st; };
__device__ __forceinline__ XcdBarrier xcd_barrier_post(unsigned* bar, volatile LAS unsigned* st) {
    XcdBarrier b; b.bar = bar; b.x = xb_xcc_id(); b.st = st;
    if (threadIdx.x == 0) (void)xb_add(&bar[XB_XCNT(b.x)], 1u);
    return b;
}
__device__ __forceinline__ void xcd_barrier_complete(unsigned* bar, unsigned x, unsigned& nloc, unsigned& nx) {
    const unsigned G = gridDim.x * gridDim.y * gridDim.z;
    unsigned sum, cnt, mine, sp = 0u;
    for (;;) {
        sum = 0u; cnt = 0u; mine = 0u;
#pragma unroll
        for (unsigned j = 0; j < 16; ++j) { const unsigned c = xb_ld(&bar[XB_XCNT(j)]); sum += c; cnt += (c > 0u) ? 1u : 0u; mine = (j == x) ? c : mine; }
        if (sum == G) break;
        __builtin_amdgcn_s_sleep(1);
        if ((++sp & 255u) == 0u) { if (xb_ld(&bar[XB_TMO])) break; if (sp > XB_SPIN_CAP) { atomicAdd(&bar[XB_TMO], 1u); break; } }
    }
    nloc = mine > 0u ? mine : 1u; nx = cnt > 0u ? cnt : 1u;
}
__device__ __forceinline__ void xcd_barrier(const int wbase, const XcdBarrier& b) {
    asm volatile("s_waitcnt vmcnt(0)" ::: "memory");
    __syncthreads();
    if (opaque_tid(wbase) == 0) {
        unsigned* bar = b.bar;
        __builtin_amdgcn_s_waitcnt(0);
        unsigned nloc = b.st[0], nx = b.st[1];
        if (nloc == 0u) { xcd_barrier_complete(bar, b.x, nloc, nx); b.st[0] = nloc; b.st[1] = nx; }
        const unsigned old = xb_add(&bar[XB_XSUB(b.x)], 1u);
        const unsigned gen = old / nloc;
        if (old + 1u == (gen + 1u) * nloc) {
            __builtin_amdgcn_fence(__ATOMIC_RELEASE, "agent");
            asm volatile("s_waitcnt vmcnt(0)" ::: "memory");
            const unsigned og = xb_add(&bar[XB_TOP], 1u);
            const unsigned tg = og / nx;
            if (og + 1u == (tg + 1u) * nx) xb_add(&bar[XB_TOPGEN], 1u);
            else XB_SPIN(xb_ld(&bar[XB_TOPGEN]) == tg, bar);
            __builtin_amdgcn_fence(__ATOMIC_ACQUIRE, "agent");
            xb_add(&bar[XB_XGEN(b.x)], 1u);
            asm volatile("s_waitcnt vmcnt(0)" ::: "memory");
        } else {
            XB_SPIN(xb_ld(&bar[XB_XGEN(b.x)]) == gen, bar);
            __builtin_amdgcn_fence(__ATOMIC_ACQUIRE, "agent");
            asm volatile("s_waitcnt vmcnt(0)" ::: "memory");
        }
    }
    __syncthreads();
}

constexpr int NPHASE = 18;
__global__ void __launch_bounds__(512, 2) fwd_megakernel(Params p) {
    extern __shared__ __attribute__((aligned(16))) unsigned char shm[];
    LAS unsigned char* lds = (LAS unsigned char*)shm;
    cg::grid_group grid = cg::this_grid();
    const int wbase = __builtin_amdgcn_readfirstlane((int)(threadIdx.x >> 6)) * 64;
    if (threadIdx.x == 0) { ((volatile LAS unsigned*)(lds + 131072))[0] = 0u; ((volatile LAS unsigned*)(lds + 131072))[1] = 0u; }
    __syncthreads();
    XcdBarrier bar = xcd_barrier_post((unsigned*)(p.ws + WS_BAR), (volatile LAS unsigned*)(lds + 131072));
    if (p.ph_lo < 0) grid.sync();
    unsigned char* ws = p.ws;
    bf16_t* mix = (bf16_t*)p.out;
#define PH_BEGIN(k) if (p.ph_lo <= (k) && (k) < p.ph_hi) { if ((k) > p.ph_lo) xcd_barrier(wbase, bar);
#define PH_GEMM(k) PH_BEGIN(k) GemmJob g; \
        g.A = nullptr; g.Bt = nullptr; g.lda = g.ldb = 2048; g.nM = g.nN = 1; g.K = 2048; g.mode = MODE_SEG; \
        g.strideAz = 0; g.strideBz = 0; g.strideBpm = 0; g.Z = 1; g.c0 = g.c1 = g.c2 = g.c3 = g.c4 = nullptr; g.ld0 = g.ld1 = g.ld2 = g.ld3 = g.ld4 = 2048; \
        g.t1 = g.t2 = g.t3 = g.t4 = 1 << 20; g.fbias = nullptr; g.resid = nullptr; g.outf = nullptr;
#define PH_END }
    PH_BEGIN(0)
        transpose_cvt(wbase, lds, p.ev_w_in, 2048, 14336, (bf16_t*)(ws + WS_WIN));
        transpose_cvt(wbase, lds, p.ev_w_out, 4096, 2048, (bf16_t*)(ws + WS_WOUT));
        build_dft(wbase, (bf16_t*)(ws + WS_DFT));
        build_w12(wbase, lds, p.fnet_w, (bf16_t*)(ws + WS_W12));
        rmsnorm_to_bf16(wbase, p.x, p.norm_w, (bf16_t*)(ws + WS_H));
    PH_END
    PH_GEMM(1)
        g.A = (const char*)(ws + WS_H); g.Bt = (const char*)(ws + WS_WIN) + (size_t)10240 * 2048 * 2; g.lda = 2048; g.ldb = 2048; g.nM = 64; g.nN = 16; g.K = 2048; g.mode = MODE_SEG;
        g.c0 = (bf16_t*)(ws + WS_S0); g.ld0 = 2048; g.c1 = mix + 2048; g.ld1 = 4096; g.t1 = 8;
        gemm_phase(wbase, lds, g);
    PH_END
    PH_BEGIN(2) fold_phase(wbase, p); PH_END
    PH_GEMM(3)
        g.A = (const char*)(ws + WS_W12); g.strideAz = (size_t)512 * 256 * 2; g.lda = 256; g.Bt = (const char*)(ws + WS_UF); g.strideBz = 256 * 2; g.ldb = 2048; g.strideBpm = (size_t)8192 * 2048 * 2;
        g.nM = 2; g.nN = 32; g.Z = 8; g.K = 256; g.mode = MODE_PT; g.c0 = (bf16_t*)(ws + WS_S2);
        gemm_phase(wbase, lds, g);
    PH_END
    PH_GEMM(4)
        g.A = (const char*)(ws + WS_DFT); g.lda = 2048; g.Bt = (const char*)(ws + WS_S2); g.strideBz = (size_t)2048 * 2048 * 2; g.ldb = 2048;
        g.nM = 8; g.nN = 8; g.Z = 8; g.K = 2048; g.mode = MODE_DFT; g.c0 = mix; g.fbias = p.fnet_b; g.resid = (const float*)(ws + WS_P1024);
        gemm_phase(wbase, lds, g);
    PH_END
    PH_GEMM(5)
        g.A = (const char*)(ws + WS_H); g.Bt = (const char*)(ws + WS_WIN); g.lda = 2048; g.ldb = 2048; g.nM = 64; g.nN = 40; g.K = 2048; g.mode = MODE_SEG;
        g.c0 = (bf16_t*)(ws + WS_S0); g.c1 = (bf16_t*)(ws + WS_S1); g.t1 = 8; g.c2 = (bf16_t*)(ws + WS_S2); g.t2 = 16; g.c3 = (bf16_t*)(ws + WS_S3); g.t3 = 24; g.c4 = mix; g.ld4 = 4096; g.t4 = 32;
        gemm_phase(wbase, lds, g);
    PH_END
    PH_BEGIN(6) gla_phase(wbase, lds, p); PH_END
    PH_BEGIN(7) post_a_phase(wbase, p); PH_END
    PH_GEMM(8)
        g.A = (const char*)mix; g.lda = 4096; g.Bt = (const char*)(ws + WS_WOUT); g.ldb = 4096; g.nM = 64; g.nN = 8; g.K = 4096; g.mode = MODE_RES0;
        g.resid = p.x; g.c0 = (bf16_t*)(ws + WS_X1);
        gemm_phase(wbase, lds, g);
    PH_END
    PH_BEGIN(9)
        transpose_cvt<true>(wbase, lds, p.od_w_in, 2048, 13376, (bf16_t*)(ws + WS_WIN));
        zero_fill16(wbase, ws + WS_WIN + (size_t)13376 * 2048 * 2, (size_t)192 * 2048 * 2);
        transpose_cvt(wbase, lds, p.od_w_out, 4096, 2048, (bf16_t*)(ws + WS_WOUT));
        rmsnorm_from_bf16<false>(wbase, (const bf16_t*)(ws + WS_X1), p.norm_w + 2048, (void*)(ws + WS_H1));
    PH_END
    PH_GEMM(10)
        g.A = (const char*)(ws + WS_H1); g.Bt = (const char*)(ws + WS_WIN); g.lda = 2048; g.ldb = 2048; g.nM = 64; g.nN = 32; g.K = 2048; g.mode = MODE_PAIR;
        g.c0 = (bf16_t*)(ws + WS_CIN); g.c1 = mix;
        gemm_phase(wbase, lds, g);
    PH_END
    PH_BEGIN(11) conv_c_phase(wbase, p); PH_END
    PH_GEMM(12)
        g.A = (const char*)(ws + WS_H1); g.Bt = (const char*)(ws + WS_WIN) + (size_t)8192 * 2048 * 2; g.lda = 2048; g.ldb = 2048; g.nM = 64; g.nN = 21; g.K = 2048; g.mode = MODE_SEG;
        g.c0 = mix + 2048; g.ld0 = 4096; g.c1 = (bf16_t*)(ws + WS_XBC); g.ld1 = 3072; g.t1 = 8; g.c2 = (bf16_t*)(ws + WS_DT); g.ld2 = 256; g.t2 = 20;
        gemm_phase(wbase, lds, g);
    PH_END
    PH_BEGIN(13) preconv_phase(wbase, p); PH_END
    PH_BEGIN(14) ssd_phase(wbase, lds, p); PH_END
    PH_BEGIN(15) post_d_phase(wbase, p); PH_END
    PH_GEMM(16)
        g.A = (const char*)mix; g.lda = 4096; g.Bt = (const char*)(ws + WS_WOUT); g.ldb = 4096; g.nM = 64; g.nN = 8; g.K = 4096; g.mode = MODE_RES1;
        g.c0 = (bf16_t*)(ws + WS_X1);
        gemm_phase(wbase, lds, g);
    PH_END
    PH_BEGIN(17) rmsnorm_from_bf16<true>(wbase, (const bf16_t*)(ws + WS_X1), p.final_norm_w, (void*)p.out); PH_END
}


extern "C" void kernel_launch(void* const* d_in, const int* in_sizes, int n_in, void* d_out, int out_size, void* d_ws, size_t ws_size, hipStream_t stream) {
    static int grid_blocks = 0;
    if (!grid_blocks) {
        int dev = 0, cus = 0, per_cu = 0;
        hipGetDevice(&dev);
        hipDeviceGetAttribute(&cus, hipDeviceAttributeMultiprocessorCount, dev);
        hipFuncSetAttribute((const void*)fwd_megakernel, hipFuncAttributeMaxDynamicSharedMemorySize, LDS_BYTES);
        hipOccupancyMaxActiveBlocksPerMultiprocessor(&per_cu, (const void*)fwd_megakernel, 512, LDS_BYTES);
        if (per_cu < 1) per_cu = 1;
        grid_blocks = cus * per_cu;
        if (grid_blocks > 256) grid_blocks = 256;
        (void)hipGetLastError();
    }
    Params p{};
    p.x = (const float*)d_in[0]; p.norm_w = (const float*)d_in[1]; p.final_norm_w = (const float*)d_in[2]; p.ev_w_in = (const float*)d_in[3]; p.ev_w_out = (const float*)d_in[4];
    p.lb_logits = (const float*)d_in[5]; p.hgrn_norm_w = (const float*)d_in[6]; p.fnet_w = (const float*)d_in[7]; p.fnet_b = (const float*)d_in[8];
    p.od_w_in = (const float*)d_in[9]; p.od_w_out = (const float*)d_in[10]; p.sconv_w = (const float*)d_in[11]; p.ssd_conv_w = (const float*)d_in[12]; p.ssd_conv_b = (const float*)d_in[13];
    p.dt_bias = (const float*)d_in[14]; p.a_log = (const float*)d_in[15]; p.ssd_d = (const float*)d_in[16]; p.ssd_norm_w = (const float*)d_in[17];
    p.out = (float*)d_out; p.ws = (unsigned char*)d_ws; p.ph_lo = 0; p.ph_hi = NPHASE;
    (void)hipMemsetAsync((unsigned char*)d_ws + WS_BAR, 0, XCD_BAR_WORDS * 4, stream);
    void* args[] = {&p};
    hipError_t e = hipLaunchCooperativeKernel((const void*)fwd_megakernel, dim3(grid_blocks), dim3(512), args, LDS_BYTES, stream);
    if (e != hipSuccess) fprintf(stderr, "cooperative launch failed: %s (grid %d)\n", hipGetErrorString(e), grid_blocks);
}
```

```cpp
#include <hip/hip_runtime.h>
#include <hip/hip_cooperative_groups.h>
#include <cstdio>
namespace cg = cooperative_groups;

#define LAS __attribute__((address_space(3)))
typedef unsigned short bf16_t;
typedef short bf16x8 __attribute__((ext_vector_type(8)));
typedef float f32x4 __attribute__((ext_vector_type(4)));
typedef float f32x2 __attribute__((ext_vector_type(2)));
typedef unsigned u32x4 __attribute__((ext_vector_type(4)));
typedef unsigned u32x2 __attribute__((ext_vector_type(2)));

constexpr int TOK = 16384, DM = 2048, SEQ = 2048;
constexpr size_t MiB = 1ull << 20;
constexpr size_t WS_WIN = 0, WS_WOUT = 56 * MiB, WS_S0 = 72 * MiB, WS_S1 = 136 * MiB, WS_S2 = 200 * MiB, WS_S3 = 264 * MiB,
                 WS_DFT = 328 * MiB, WS_W12 = 344 * MiB, WS_P1024 = 346 * MiB, WS_H = 348 * MiB, WS_UF = 412 * MiB;
constexpr size_t WS_X1 = WS_S0, WS_H1 = 200 * MiB, WS_CIN = 264 * MiB, WS_CB = 328 * MiB, WS_CC = 392 * MiB,
                 WS_XBC = 264 * MiB, WS_DT = 360 * MiB, WS_YF = 368 * MiB, WS_YB = 432 * MiB,
                 WS_XACT = 200 * MiB  , WS_BCACT = 0  ;
constexpr int LDS_BYTES = 131072 + 16;
constexpr float EPS = 1e-6f;

struct Params {
    const float* x; const float* norm_w; const float* final_norm_w; const float* ev_w_in; const float* ev_w_out;
    const float* lb_logits; const float* hgrn_norm_w; const float* fnet_w; const float* fnet_b;
    const float* od_w_in; const float* od_w_out; const float* sconv_w; const float* ssd_conv_w; const float* ssd_conv_b;
    const float* dt_bias; const float* a_log; const float* ssd_d; const float* ssd_norm_w;
    float* out; unsigned char* ws;
    int ph_lo, ph_hi;
};

typedef __bf16 bf16x2_t __attribute__((ext_vector_type(2)));
__device__ __forceinline__ unsigned cvt_pk_bf16(float lo, float hi) {
    f32x2 v = {lo, hi}; union { bf16x2_t b; unsigned u; } c; c.b = __builtin_convertvector(v, bf16x2_t); return c.u; }
__device__ __forceinline__ float bf_lo(unsigned w) { return __uint_as_float(w << 16); }
__device__ __forceinline__ float bf_hi(unsigned w) { return __uint_as_float(w & 0xffff0000u); }
__device__ __forceinline__ void unpack8(const u32x4 v, float* f) {
    f[0] = bf_lo(v[0]); f[1] = bf_hi(v[0]); f[2] = bf_lo(v[1]); f[3] = bf_hi(v[1]);
    f[4] = bf_lo(v[2]); f[5] = bf_hi(v[2]); f[6] = bf_lo(v[3]); f[7] = bf_hi(v[3]);
}
__device__ __forceinline__ u32x4 pack8(const float* f) {
    u32x4 r; r[0] = cvt_pk_bf16(f[0], f[1]); r[1] = cvt_pk_bf16(f[2], f[3]); r[2] = cvt_pk_bf16(f[4], f[5]); r[3] = cvt_pk_bf16(f[6], f[7]); return r;
}
__device__ __forceinline__ float silu_f(float x) { return x * __builtin_amdgcn_rcpf(1.0f + __expf(-x)); }
__device__ __forceinline__ bf16x8 as_bf16x8(u32x4 v) { union { u32x4 u; bf16x8 b; } c; c.u = v; return c.b; }
__device__ __forceinline__ bf16x8 lds_b128(LAS unsigned char* p) { return *(LAS bf16x8*)p; }
__device__ __forceinline__ bf16x8 lds_2xb64(LAS unsigned char* p0, LAS unsigned char* p1) {
    u32x2 a = *(LAS u32x2*)p0, b = *(LAS u32x2*)p1; u32x4 v; v[0] = a[0]; v[1] = a[1]; v[2] = b[0]; v[3] = b[1]; return as_bf16x8(v);
}
__device__ __forceinline__ bf16x8 pack_acc2(const f32x4 a, const f32x4 b) {
    u32x4 v; v[0] = cvt_pk_bf16(a[0], a[1]); v[1] = cvt_pk_bf16(a[2], a[3]); v[2] = cvt_pk_bf16(b[0], b[1]); v[3] = cvt_pk_bf16(b[2], b[3]); return as_bf16x8(v);
}
__device__ __forceinline__ int opaque_tid(const int wbase) { int t = wbase + (int)__builtin_amdgcn_mbcnt_hi(~0u, __builtin_amdgcn_mbcnt_lo(~0u, 0u)); asm volatile("" : "+v"(t)); return t; }
typedef short s16x4 __attribute__((ext_vector_type(4)));
constexpr int PN = 288;
__device__ __forceinline__ int rowaddr(int r) { return r * PN + ((r >> 3) & 7) * 16; }
__device__ __forceinline__ bf16x8 lds_tr_frag(LAS unsigned char* base, int r0, int c0, int lane) {
    const int g = lane >> 4, q = (lane & 15) >> 2, pp = lane & 3;
    LAS unsigned char* a0 = base + rowaddr(r0 + 8 * g + q) + c0 * 2 + 8 * pp;
    const s16x4 lo = __builtin_amdgcn_ds_read_tr16_b64_v4i16((LAS s16x4*)a0);
    const s16x4 hi = __builtin_amdgcn_ds_read_tr16_b64_v4i16((LAS s16x4*)(a0 + 4 * PN));
    bf16x8 r; r[0] = lo[0]; r[1] = lo[1]; r[2] = lo[2]; r[3] = lo[3]; r[4] = hi[0]; r[5] = hi[1]; r[6] = hi[2]; r[7] = hi[3]; return r;
}
#define MFMA16(a, b, c) __builtin_amdgcn_mfma_f32_16x16x32_bf16((a), (b), (c), 0, 0, 0)

constexpr int BM = 256, BK = 64, HALF = 128, HTB = HALF * BK * 2, NXCD = 8, WGM = 4;
__device__ __forceinline__ int lds_byte(int r, int c) { const int st = (r >> 4) * 2 + (c >> 5), rr = r & 15, cc = c & 31, ob = rr * 64 + cc * 2; return st * 1024 + (ob ^ (((ob >> 9) & 1) << 5)); }
__device__ __forceinline__ void stage_rc(int b, int& R, int& C) { const int st = b / 1024, sb = b % 1024, swz = sb ^ (((sb >> 9) & 1) << 5); R = (st >> 1) * 16 + swz / 64; C = (st & 1) * 32 + (swz % 64) / 2; }
__device__ __forceinline__ int perm32(int rho) { const int n = rho >> 4, i = rho & 15; return 8 * (i >> 2) + 4 * n + (i & 3); }

__device__ __forceinline__ bf16_t* rfl_ptr(bf16_t* p) { const unsigned long long v = (unsigned long long)p; const unsigned lo = __builtin_amdgcn_readfirstlane((unsigned)v), hi = __builtin_amdgcn_readfirstlane((unsigned)(v >> 32)); return (bf16_t*)(((unsigned long long)hi << 32) | lo); }
enum { MODE_SEG = 0, MODE_PT = 1, MODE_DFT = 2, MODE_RES0 = 3, MODE_RES1 = 4, MODE_PAIR = 5 };
struct GemmJob {
    const char* A; const char* Bt; size_t strideAz, strideBz, strideBpm;
    int lda, ldb, nM, nN, Z, K, mode;
    bf16_t* c0; bf16_t* c1; bf16_t* c2; bf16_t* c3; bf16_t* c4;
    int ld0, ld1, ld2, ld3, ld4, t1, t2, t3, t4;
    const float* fbias; const float* resid; float* outf;
};
struct Unit { int z, pm, pn; };

__device__ __forceinline__ bool next_unit(const GemmJob& g, int i, Unit& u) {
    const int nwg = g.nM * g.nN;
    const long L = (long)i * gridDim.x + blockIdx.x;
    if (L >= (long)g.Z * nwg) return false;
    const int z = (int)(L / nwg); int wgid = (int)(L - (long)z * nwg);
    { const int q = nwg / NXCD, r = nwg % NXCD, xcd = wgid % NXCD, off = wgid / NXCD; wgid = (xcd < r ? xcd * (q + 1) : r * (q + 1) + (xcd - r) * q) + off; }
    const int nig = WGM * g.nN, gid = wgid / nig, fm = gid * WGM, gsz = (g.nM - fm) < WGM ? (g.nM - fm) : WGM;
    u.pm = fm + ((wgid % nig) % gsz); u.pn = (wgid % nig) / gsz; u.z = z; return true;
}

__device__ __forceinline__ void gemm_epilogue(const f32x4 (&acc)[2][2][4][2], const GemmJob& g, const Unit& u, int wr, int wc, int fr, int fq) {
    const int rloc = wr * 64 + fr, cloc = wc * 32 + 8 * fq;
    if (g.mode == MODE_SEG || g.mode == MODE_PT) {
        bf16_t* base; int ld;
        if (g.mode == MODE_SEG) {
            bf16_t* s0 = g.c0; bf16_t* s1 = g.c1; bf16_t* s2 = g.c2; bf16_t* s3 = g.c3; bf16_t* s4 = g.c4;
            int e0 = g.ld0, e1 = g.ld1, e2 = g.ld2, e3 = g.ld3, e4 = g.ld4, f1 = g.t1, f2 = g.t2, f3 = g.t3, f4 = g.t4;
            s0 = rfl_ptr(s0); s1 = rfl_ptr(s1); s2 = rfl_ptr(s2); s3 = rfl_ptr(s3); s4 = rfl_ptr(s4);
            e0 = __builtin_amdgcn_readfirstlane(e0); e1 = __builtin_amdgcn_readfirstlane(e1); e2 = __builtin_amdgcn_readfirstlane(e2); e3 = __builtin_amdgcn_readfirstlane(e3); e4 = __builtin_amdgcn_readfirstlane(e4);
            f1 = __builtin_amdgcn_readfirstlane(f1); f2 = __builtin_amdgcn_readfirstlane(f2); f3 = __builtin_amdgcn_readfirstlane(f3); f4 = __builtin_amdgcn_readfirstlane(f4);
            base = s0; ld = e0; int t0 = 0;
            if (u.pn >= f1) { base = s1; ld = e1; t0 = f1; }
            if (u.pn >= f2) { base = s2; ld = e2; t0 = f2; }
            if (u.pn >= f3) { base = s3; ld = e3; t0 = f3; }
            if (u.pn >= f4) { base = s4; ld = e4; t0 = f4; }
            base += (size_t)(u.pm * BM) * ld + (size_t)(u.pn - t0) * BM;
        } else {
            const int b = u.pn >> 2, l0 = (u.pn & 3) * 256; ld = 2048;
            base = g.c0 + ((size_t)(b * 2048 + u.z * 256)) * 2048 + (size_t)u.pm * 1024 + l0;
        }
#pragma unroll
        for (int ai = 0; ai < 2; ++ai)
#pragma unroll
            for (int m = 0; m < 4; ++m) {
                bf16_t* rowp = base + (size_t)(rloc + ai * HALF + m * 16) * ld + cloc;
#pragma unroll
                for (int bj = 0; bj < 2; ++bj) {
                    const f32x4 v0 = acc[ai][bj][m][0], v1 = acc[ai][bj][m][1];
                    u32x4 o; o[0] = cvt_pk_bf16(v0[0], v0[1]); o[1] = cvt_pk_bf16(v0[2], v0[3]); o[2] = cvt_pk_bf16(v1[0], v1[1]); o[3] = cvt_pk_bf16(v1[2], v1[3]);
                    *(u32x4*)(rowp + bj * HALF) = o;
                }
            }
    } else if (g.mode == MODE_PAIR) {
        const bool second = u.pn >= 16;
        bf16_t* base = second ? g.c1 : g.c0; const int ld = second ? 4096 : 2048;
        base += (size_t)(u.pm * BM) * ld + (size_t)(u.pn & 15) * 128 + cloc;
#pragma unroll
        for (int ai = 0; ai < 2; ++ai)
#pragma unroll
            for (int m = 0; m < 4; ++m) {
                float r[8];
#pragma unroll
                for (int e = 0; e < 4; ++e) {
                    const float a0 = acc[ai][0][m][0][e], a1 = acc[ai][0][m][1][e], p0 = acc[ai][1][m][0][e], p1 = acc[ai][1][m][1][e];
                    r[e] = second ? a0 * silu_f(p0) : a0 * p0; r[4 + e] = second ? a1 * silu_f(p1) : a1 * p1;
                }
                *(u32x4*)(base + (size_t)(rloc + ai * HALF + m * 16) * ld) = pack8(r);
            }
    } else if (g.mode == MODE_DFT) {
        const int col0 = u.pn * BM + cloc;
        const float sgn = (fr & 1) ? -1.0f : 1.0f;
#pragma unroll
        for (int bj = 0; bj < 2; ++bj) {
            const f32x4 q0 = *(const f32x4*)(g.resid + u.z * 2048 + col0 + bj * HALF), q1 = *(const f32x4*)(g.resid + u.z * 2048 + col0 + bj * HALF + 4);
            const f32x4 b0 = *(const f32x4*)(g.fbias + col0 + bj * HALF) + q0 * sgn, b1 = *(const f32x4*)(g.fbias + col0 + bj * HALF + 4) + q1 * sgn;
            bf16_t* pp0 = g.c0 + (size_t)(u.z * 2048 + u.pm * BM + rloc) * 4096 + 2048 + col0 + bj * HALF;
            u32x4 gt[2][4];
#pragma unroll
            for (int ai = 0; ai < 2; ++ai)
#pragma unroll
                for (int m = 0; m < 4; ++m) gt[ai][m] = *(const u32x4*)(pp0 + (size_t)(ai * HALF + m * 16) * 4096);
#pragma unroll
            for (int ai = 0; ai < 2; ++ai)
#pragma unroll
                for (int m = 0; m < 4; ++m) {
                    float gf[8]; unpack8(gt[ai][m], gf);
                    const f32x4 v0 = acc[ai][bj][m][0] + b0, v1 = acc[ai][bj][m][1] + b1;
                    float r[8];
#pragma unroll
                    for (int e = 0; e < 4; ++e) { r[e] = v0[e] * silu_f(gf[e]); r[4 + e] = v1[e] * silu_f(gf[4 + e]); }
                    *(u32x4*)(pp0 + (size_t)(ai * HALF + m * 16) * 4096) = pack8(r);
                }
        }
    } else {
#pragma unroll
        for (int ai = 0; ai < 2; ++ai) {
            const size_t ro0 = (size_t)(u.pm * BM + rloc + ai * HALF) * 2048 + u.pn * BM + cloc;
            float rr[4][2][8];
            if (g.mode == MODE_RES0) {
                f32x4 t0[4][2], t1[4][2];
#pragma unroll
                for (int m = 0; m < 4; ++m)
#pragma unroll
                    for (int bj = 0; bj < 2; ++bj) { t0[m][bj] = *(const f32x4*)(g.resid + ro0 + (size_t)m * 16 * 2048 + bj * HALF); t1[m][bj] = *(const f32x4*)(g.resid + ro0 + (size_t)m * 16 * 2048 + bj * HALF + 4); }
#pragma unroll
                for (int m = 0; m < 4; ++m)
#pragma unroll
                    for (int bj = 0; bj < 2; ++bj)
#pragma unroll
                        for (int e = 0; e < 4; ++e) { rr[m][bj][e] = t0[m][bj][e]; rr[m][bj][4 + e] = t1[m][bj][e]; }
            } else {
                u32x4 t[4][2];
#pragma unroll
                for (int m = 0; m < 4; ++m)
#pragma unroll
                    for (int bj = 0; bj < 2; ++bj) t[m][bj] = *(const u32x4*)(g.c0 + ro0 + (size_t)m * 16 * 2048 + bj * HALF);
#pragma unroll
                for (int m = 0; m < 4; ++m)
#pragma unroll
                    for (int bj = 0; bj < 2; ++bj) unpack8(t[m][bj], rr[m][bj]);
            }
#pragma unroll
            for (int m = 0; m < 4; ++m)
#pragma unroll
                for (int bj = 0; bj < 2; ++bj) {
#pragma unroll
                    for (int e = 0; e < 4; ++e) { rr[m][bj][e] += acc[ai][bj][m][0][e]; rr[m][bj][4 + e] += acc[ai][bj][m][1][e]; }
                    *(u32x4*)(g.c0 + ro0 + (size_t)m * 16 * 2048 + bj * HALF) = pack8(rr[m][bj]);
                }
        }
    }
}

__device__ __forceinline__ void gemm_phase(const int wbase, LAS unsigned char* lds, const GemmJob& g) {
    const int tid = opaque_tid(wbase), wid = __builtin_amdgcn_readfirstlane(tid >> 6), lane = tid & 63, wr = wid >> 2, wc = wid & 3, fr = lane & 15, fq = lane >> 4;
    const int K = g.K, nt = K / BK;
    unsigned voffA[2], voffB[2];
#pragma unroll
    for (int i = 0; i < 2; ++i) { int R, C; stage_rc(tid * 16 + i * 8192, R, C); const int Rb = (R & ~31) + perm32(R & 31);
        voffA[i] = (unsigned)(R * g.lda + C) * 2u; voffB[i] = (unsigned)(Rb * g.ldb + C) * 2u; }
    const size_t kstep = (size_t)(BK * 2);
    const size_t hstepA = (size_t)HALF * g.lda * 2, hstepB = (size_t)HALF * g.ldb * 2;
    const unsigned ldsw = (unsigned)wid * 1024u;
    const int aoff = lds_byte(wr * 64 + fr, fq * 8), boff = lds_byte(wc * 32 + fr, fq * 8);
#define PG8_SA(b, h) (((b) * 2 + (h)) * HTB)
#define PG8_SB(b, h) ((4 + (b) * 2 + (h)) * HTB)
#define PG8_STAGE(bufoff, gbase, voff) do { _Pragma("unroll") for (int _i = 0; _i < 2; ++_i) \
        __builtin_amdgcn_global_load_lds((const unsigned*)((const char*)(gbase) + (voff)[_i]), (LAS unsigned*)(lds + (bufoff) + ldsw + _i * 8192), 16, 0, 0); } while (0)
#define PG8_LDA(dst, b, h) do { _Pragma("unroll") for (int m = 0; m < 4; ++m) _Pragma("unroll") for (int k = 0; k < 2; ++k) dst[m][k] = *(const LAS bf16x8*)(lds + PG8_SA(b, h) + aoff + m * 2048 + k * 1024); } while (0)
#define PG8_LDB(dst, b, h) do { _Pragma("unroll") for (int n = 0; n < 2; ++n) _Pragma("unroll") for (int k = 0; k < 2; ++k) dst[n][k] = *(const LAS bf16x8*)(lds + PG8_SB(b, h) + boff + n * 2048 + k * 1024); } while (0)
#define PG8_MMA(ai, bj, At, Bt) do { __builtin_amdgcn_s_setprio(1); _Pragma("unroll") for (int m = 0; m < 4; ++m) _Pragma("unroll") for (int n = 0; n < 2; ++n) _Pragma("unroll") for (int k = 0; k < 2; ++k) \
        acc[ai][bj][m][n] = __builtin_amdgcn_mfma_f32_16x16x32_bf16(Bt[n][k], At[m][k], acc[ai][bj][m][n], 0, 0, 0); __builtin_amdgcn_s_setprio(0); } while (0)
#define PG8_WAIT_V(n) asm volatile("s_waitcnt vmcnt(" #n ")" ::: "memory")
#define PG8_WAIT_L(n) asm volatile("s_waitcnt lgkmcnt(" #n ")" ::: "memory")
#define PG8_BAR __builtin_amdgcn_s_barrier()
#define PG8_SCHED __builtin_amdgcn_sched_barrier(0)
    Unit cur, nxt; int ui = 0;
    if (!next_unit(g, 0, cur)) return;
    f32x4 acc[2][2][4][2];
#pragma unroll
    for (int a = 0; a < 2; ++a)
#pragma unroll
        for (int b = 0; b < 2; ++b)
#pragma unroll
            for (int m = 0; m < 4; ++m)
#pragma unroll
                for (int n = 0; n < 2; ++n) acc[a][b][m][n] = (f32x4){0.f, 0.f, 0.f, 0.f};
    bf16x8 At[4][2], B0[2][2], B1[2][2];
    const char* cA = g.A + (size_t)cur.z * g.strideAz + (size_t)cur.pm * 2 * hstepA;
    const char* cB = g.Bt + (size_t)cur.z * g.strideBz + (size_t)cur.pn * 2 * hstepB + (size_t)cur.pm * g.strideBpm;
    PG8_STAGE(PG8_SB(0, 0), cB, voffB); PG8_STAGE(PG8_SA(0, 0), cA, voffA); PG8_STAGE(PG8_SB(0, 1), cB + hstepB, voffB); PG8_STAGE(PG8_SA(0, 1), cA + hstepA, voffA);
    if (wr == 1) PG8_BAR;
    PG8_WAIT_V(4); PG8_BAR;
    PG8_STAGE(PG8_SB(1, 0), cB + kstep, voffB); PG8_STAGE(PG8_SA(1, 0), cA + kstep, voffA); PG8_STAGE(PG8_SB(1, 1), cB + hstepB + kstep, voffB);
    PG8_WAIT_V(6); PG8_BAR;
    for (;;) {
        const bool has_next = next_unit(g, ui + 1, nxt);
        const char* nA = has_next ? g.A + (size_t)nxt.z * g.strideAz + (size_t)nxt.pm * 2 * hstepA : cA;
        const char* nB = has_next ? g.Bt + (size_t)nxt.z * g.strideBz + (size_t)nxt.pn * 2 * hstepB + (size_t)nxt.pm * g.strideBpm : cB;
        for (int t = 0; t < nt; t += 2) {
            const bool last = (t == nt - 2);
            const char* a1 = cA + (size_t)(t + 1) * kstep;
            const char* a2 = last ? nA : cA + (size_t)(t + 2) * kstep; const char* b2 = last ? nB : cB + (size_t)(t + 2) * kstep;
            const char* a3 = a2 + kstep; const char* b3 = b2 + kstep;
            PG8_LDB(B0, 0, 0); PG8_SCHED; PG8_LDA(At, 0, 0); PG8_STAGE(PG8_SA(1, 1), a1 + hstepA, voffA);
            PG8_WAIT_L(8); PG8_BAR; PG8_WAIT_L(0); PG8_MMA(0, 0, At, B0); PG8_BAR; PG8_SCHED;
            PG8_LDB(B1, 0, 1); PG8_STAGE(PG8_SB(0, 0), b2, voffB);
            PG8_BAR; PG8_WAIT_L(0); PG8_MMA(0, 1, At, B1); PG8_BAR;
            PG8_LDA(At, 0, 1); PG8_STAGE(PG8_SA(0, 0), a2, voffA);
            PG8_BAR; PG8_WAIT_L(0); PG8_MMA(1, 0, At, B0); PG8_BAR; PG8_SCHED;
            PG8_STAGE(PG8_SB(0, 1), b2 + hstepB, voffB);
            PG8_WAIT_V(6); PG8_BAR; PG8_MMA(1, 1, At, B1); PG8_BAR;
            PG8_LDB(B0, 1, 0); PG8_SCHED; PG8_LDA(At, 1, 0); PG8_STAGE(PG8_SA(0, 1), a2 + hstepA, voffA);
            PG8_WAIT_L(8); PG8_BAR; PG8_WAIT_L(0); PG8_MMA(0, 0, At, B0); PG8_BAR; PG8_SCHED;
            PG8_LDB(B1, 1, 1); PG8_STAGE(PG8_SB(1, 0), b3, voffB);
            PG8_BAR; PG8_WAIT_L(0); PG8_MMA(0, 1, At, B1); PG8_BAR;
            PG8_LDA(At, 1, 1); PG8_STAGE(PG8_SA(1, 0), a3, voffA);
            PG8_BAR; PG8_WAIT_L(0); PG8_MMA(1, 0, At, B0); PG8_BAR; PG8_SCHED;
            PG8_STAGE(PG8_SB(1, 1), b3 + hstepB, voffB);
            PG8_WAIT_V(6); PG8_BAR; PG8_MMA(1, 1, At, B1); PG8_BAR;
        }
        gemm_epilogue(acc, g, cur, wr, wc, fr, fq);
        if (!has_next) break;
#pragma unroll
        for (int a = 0; a < 2; ++a)
#pragma unroll
            for (int b = 0; b < 2; ++b)
#pragma unroll
                for (int m = 0; m < 4; ++m)
#pragma unroll
                    for (int n = 0; n < 2; ++n) acc[a][b][m][n] = (f32x4){0.f, 0.f, 0.f, 0.f};
        cur = nxt; cA = nA; cB = nB; ++ui;
    }
    PG8_WAIT_V(0);
    if (wr == 0) PG8_BAR;
    PG8_BAR;
#undef PG8_SA
#undef PG8_SB
#undef PG8_STAGE
#undef PG8_LDA
#undef PG8_LDB
#undef PG8_MMA
#undef PG8_WAIT_V
#undef PG8_WAIT_L
#undef PG8_BAR
#undef PG8_SCHED
}

__device__ __forceinline__ int pair_row(int n) {
    if (n >= 8192) return n;
    const int seg = n >> 11, ch = n & 2047, t = ch >> 7, j = ch & 127;
    return ((seg & 1) ? 4096 : 0) + 256 * t + ((seg & 2) ? 128 : 0) + j;
}
template <bool PAIRMAP = false>
__device__ __forceinline__ void transpose_cvt(const int wbase, LAS unsigned char* lds, const float* __restrict__ src, int Kr, int Nc, bf16_t* __restrict__ dst) {
    constexpr int TP = 544;
    const int tid = opaque_tid(wbase), wid = tid >> 6, lane = tid & 63;
    const int npn = (Nc + 255) / 256, npk = Kr / 64, npan = npn * npk;
    const int kr = tid >> 3, q = tid & 7;
    const int g = lane >> 4, qq = (lane & 15) >> 2, pp = lane & 3;
    f32x4 v[8], vn[8];
    auto load_panel = [&](int idx, f32x4 (&dstv)[8]) {
        idx = idx < npan ? idx : npan - 1;
        const int n0 = (idx % npn) * 256, k0 = (idx / npn) * 64;
#pragma unroll
        for (int j = 0; j < 8; ++j) {
            int n = n0 + (q + 8 * j) * 4; n = n < Nc ? n : Nc - 4;
            dstv[j] = *(const f32x4*)(src + (size_t)(k0 + kr) * Nc + n);
        }
    };
    load_panel(blockIdx.x, v);
    for (int idx = blockIdx.x; idx < npan; idx += gridDim.x) {
        const int n0 = (idx % npn) * 256, k0 = (idx / npn) * 64;
        load_panel(idx + gridDim.x, vn);
        __syncthreads();
#pragma unroll
        for (int j = 0; j < 8; ++j) {
            u32x2 o; o[0] = cvt_pk_bf16(v[j][0], v[j][1]); o[1] = cvt_pk_bf16(v[j][2], v[j][3]);
            *(LAS u32x2*)(lds + kr * TP + (q + 8 * j) * 8) = o;
        }
        __syncthreads();
#pragma unroll
        for (int it = 0; it < 4; ++it) {
            const int f = wid * 4 + it, r0 = (f & 1) * 32, c0 = (f >> 1) * 16;
            LAS unsigned char* a0 = lds + (r0 + 8 * g + qq) * TP + c0 * 2 + 8 * pp;
            const s16x4 lo = __builtin_amdgcn_ds_read_tr16_b64_v4i16((LAS s16x4*)a0);
            const s16x4 hi = __builtin_amdgcn_ds_read_tr16_b64_v4i16((LAS s16x4*)(a0 + 4 * TP));
            const int n = n0 + c0 + (lane & 15);
            union { s16x4 h[2]; u32x4 u; } cv; cv.h[0] = lo; cv.h[1] = hi;
            if (n < Nc) *(u32x4*)(dst + (size_t)(PAIRMAP ? pair_row(n) : n) * Kr + k0 + r0 + 8 * g) = cv.u;
        }
#pragma unroll
        for (int j = 0; j < 8; ++j) v[j] = vn[j];
    }
    __syncthreads();
}

__device__ __forceinline__ void rmsnorm_to_bf16(const int wbase, const float* __restrict__ x, const float* __restrict__ w, bf16_t* __restrict__ out) {
    const int tid_ = opaque_tid(wbase); const int lane = tid_ & 63, wv = blockIdx.x * 8 + (tid_ >> 6), nwv = gridDim.x * 8;
    for (int row = wv; row < TOK; row += nwv) {
        f32x4 v[8]; float ss = 0.f;
#pragma unroll
        for (int i = 0; i < 8; ++i) { v[i] = *(const f32x4*)(x + (size_t)row * DM + i * 256 + lane * 4); ss += v[i][0] * v[i][0] + v[i][1] * v[i][1] + v[i][2] * v[i][2] + v[i][3] * v[i][3]; }
#pragma unroll
        for (int s = 32; s >= 1; s >>= 1) ss += __shfl_xor(ss, s);
        const float rs = rsqrtf(ss * (1.0f / DM) + EPS);
#pragma unroll
        for (int i = 0; i < 8; ++i) {
            const f32x4 w4 = *(const f32x4*)(w + i * 256 + lane * 4);
            u32x2 o; o[0] = cvt_pk_bf16(v[i][0] * rs * w4[0], v[i][1] * rs * w4[1]); o[1] = cvt_pk_bf16(v[i][2] * rs * w4[2], v[i][3] * rs * w4[3]);
            *(u32x2*)(out + (size_t)row * DM + i * 256 + lane * 4) = o;
        }
    }
}

template <bool TO_F32> __device__ __forceinline__ void rmsnorm_from_bf16(const int wbase, const bf16_t* __restrict__ x, const float* __restrict__ w, void* __restrict__ outp) {
    const int tid_ = opaque_tid(wbase); const int lane = tid_ & 63, wv = blockIdx.x * 8 + (tid_ >> 6), nwv = gridDim.x * 8;
    float nw[4][8];
#pragma unroll
    for (int i = 0; i < 4; ++i) {
        const int c8 = (i * 64 + lane) * 8;
        const f32x4 w0 = *(const f32x4*)(w + c8), w1 = *(const f32x4*)(w + c8 + 4);
#pragma unroll
        for (int e = 0; e < 8; ++e) nw[i][e] = e < 4 ? w0[e & 3] : w1[e & 3];
    }
    for (int row = wv; row < TOK; row += nwv) {
        float v[4][8]; float ss = 0.f;
#pragma unroll
        for (int i = 0; i < 4; ++i) {
            unpack8(*(const u32x4*)(x + (size_t)row * DM + (i * 64 + lane) * 8), v[i]);
#pragma unroll
            for (int e = 0; e < 8; ++e) ss += v[i][e] * v[i][e];
        }
#pragma unroll
        for (int s = 32; s >= 1; s >>= 1) ss += __shfl_xor(ss, s);
        const float rs = rsqrtf(ss * (1.0f / DM) + EPS);
#pragma unroll
        for (int i = 0; i < 4; ++i) {
            const int c8 = (i * 64 + lane) * 8;
            float o[8];
#pragma unroll
            for (int e = 0; e < 8; ++e) o[e] = v[i][e] * rs * nw[i][e];
            if (TO_F32) {
                float* op = (float*)outp + (size_t)row * DM + c8;
                *(f32x4*)op = (f32x4){o[0], o[1], o[2], o[3]}; *(f32x4*)(op + 4) = (f32x4){o[4], o[5], o[6], o[7]};
            } else *(u32x4*)((bf16_t*)outp + (size_t)row * DM + c8) = pack8(o);
        }
    }
}

__device__ __forceinline__ void build_dft(const int wbase, bf16_t* __restrict__ dft) {
    const size_t gt = (size_t)blockIdx.x * 512 + opaque_tid(wbase), nth = (size_t)gridDim.x * 512;
    for (size_t pidx = gt; pidx < (size_t)2048 * 256; pidx += nth) {
        const int k = (int)(pidx >> 8), j0 = (int)(pidx & 255) * 8;
        float f[8];
#pragma unroll
        for (int e = 0; e < 8; ++e) {
            const int j = j0 + e, l = j & 1023;
            const float rev = (float)((k * l) & 2047) * (1.0f / 2048.0f);
            f[e] = (j < 1024) ? __builtin_amdgcn_cosf(rev) : -__builtin_amdgcn_sinf(rev);
        }
        *(u32x4*)(dft + (size_t)k * 2048 + j0) = pack8(f);
    }
}

__device__ __forceinline__ void fold_phase(const int wbase, const Params& p) {
    const bf16_t* bu = (const bf16_t*)(p.ws + WS_S0); bf16_t* uf = (bf16_t*)(p.ws + WS_UF);
    const bf16_t* w12 = (const bf16_t*)(p.ws + WS_W12); float* p1024 = (float*)(p.ws + WS_P1024);
    const size_t gt = (size_t)blockIdx.x * 512 + opaque_tid(wbase), nth = (size_t)gridDim.x * 512;
    for (size_t pc = gt; pc < (size_t)8 * 1024 * 256; pc += nth) {
        const int c8 = (int)(pc & 255) * 8, l = (int)(pc >> 8) & 1023, b = (int)(pc >> 18);
        float a[8], m[8], ue[8], uo[8];
        unpack8(*(const u32x4*)(bu + (size_t)(b * 2048 + l) * 2048 + c8), a);
        if (l > 0) {
            unpack8(*(const u32x4*)(bu + (size_t)(b * 2048 + 2048 - l) * 2048 + c8), m);
#pragma unroll
            for (int e = 0; e < 8; ++e) { ue[e] = a[e] + m[e]; uo[e] = a[e] - m[e]; }
        } else {
#pragma unroll
            for (int e = 0; e < 8; ++e) { ue[e] = a[e]; uo[e] = 0.f; }
        }
        *(u32x4*)(uf + (size_t)(b * 1024 + l) * 2048 + c8) = pack8(ue);
        *(u32x4*)(uf + (size_t)(8192 + b * 1024 + l) * 2048 + c8) = pack8(uo);
    }
    if (gt < 16384) {
        const int b = (int)(gt >> 11), ch = (int)(gt & 2047), g = ch >> 8, d = ch & 255;
        const bf16_t* up = bu + (size_t)(b * 2048 + 1024) * 2048 + g * 256; const bf16_t* wp = w12 + (size_t)g * 512 * 256 + (size_t)d * 256;
        float acc = 0.f;
#pragma unroll 4
        for (int c = 0; c < 256; c += 8) {
            float u[8], w[8]; unpack8(*(const u32x4*)(up + c), u); unpack8(*(const u32x4*)(wp + c), w);
#pragma unroll
            for (int e = 0; e < 8; ++e) acc += u[e] * w[e];
        }
        p1024[gt] = acc;
    }
}

__device__ __forceinline__ void build_w12(const int wbase, LAS unsigned char* lds, const float* __restrict__ fw, bf16_t* __restrict__ w12) {
    LAS float* fwl = (LAS float*)lds;
    LAS float* ctab = (LAS float*)(lds + 65536); LAS float* stab = ctab + 256;
    const int tid = opaque_tid(wbase), wid = tid >> 6, lane = tid & 63;
    const float scale = 1.0f / sqrtf(2048.0f * 256.0f);
    for (int task = blockIdx.x; task < 256; task += gridDim.x) {
        const int g = task >> 5, d0 = ((task >> 3) & 3) * 64, c0 = (task & 7) * 32;
        __syncthreads();
        if (tid < 256) { const float ang = (float)tid * (1.0f / 128.0f); ctab[tid] = cospif(ang); stab[tid] = sinpif(ang); }
#pragma unroll
        for (int j = 0; j < 8; ++j) {
            const int m = j * 32 + (tid >> 4), dd = (tid & 15) * 4;
            *(LAS f32x4*)(fwl + m * 64 + dd) = *(const f32x4*)(fw + (size_t)g * 65536 + (size_t)m * 256 + d0 + dd);
        }
        __syncthreads();
        const int cb = c0 + wid * 4;
        float ac[4] = {0.f, 0.f, 0.f, 0.f}, as[4] = {0.f, 0.f, 0.f, 0.f};
#pragma unroll 8
        for (int m = 0; m < 256; ++m) {
            const float v = fwl[m * 64 + lane];
#pragma unroll
            for (int cc = 0; cc < 4; ++cc) { const int ti = (m * (cb + cc)) & 255; ac[cc] += ctab[ti] * v; as[cc] += stab[ti] * v; }
        }
        bf16_t* o = w12 + (size_t)g * 512 * 256 + (size_t)(d0 + lane) * 256 + cb;
        u32x2 oc, os; oc[0] = cvt_pk_bf16(ac[0] * scale, ac[1] * scale); oc[1] = cvt_pk_bf16(ac[2] * scale, ac[3] * scale);
        os[0] = cvt_pk_bf16(as[0] * scale, as[1] * scale); os[1] = cvt_pk_bf16(as[2] * scale, as[3] * scale);
        *(u32x2*)o = oc; *(u32x2*)(o + 256 * 256) = os;
    }
    __syncthreads();
}

__device__ __forceinline__ void zero_fill16(const int wbase, unsigned char* p, size_t bytes) {
    const size_t gt = (size_t)blockIdx.x * 512 + opaque_tid(wbase), nth = (size_t)gridDim.x * 512;
    for (size_t i = gt; i < bytes / 16; i += nth) *(u32x4*)(p + i * 16) = (u32x4){0u, 0u, 0u, 0u};
}

__device__ __forceinline__ void gla_phase(const int wbase, LAS unsigned char* lds, const Params& p) {
    constexpr int G_OFF = 0, QIN_OFF = 16384, KIN_OFF = 25728, KET_OFF = 35072, VT_OFF = 44416, SC_OFF = 53760, EB_OFF = 56320;
    constexpr int TLD = 80;
    const int tid = opaque_tid(wbase), wid = __builtin_amdgcn_readfirstlane(tid >> 6), lane = tid & 63, fr = lane & 15, fq = lane >> 4;
    const int r = tid >> 4, c8 = (tid & 15) * 8;
    const bf16_t* qb = (const bf16_t*)(p.ws + WS_S0); const bf16_t* vb = (const bf16_t*)(p.ws + WS_S1);
    for (int item = blockIdx.x; item < 256; item += gridDim.x) {
        const int xcd = item & 7, slot = item >> 3, dir = slot & 1, bh = (slot >> 1) * 8 + xcd, b = bh >> 4, h = bh & 15;
        bf16_t* zb = (bf16_t*)(p.ws + (dir ? WS_S3 : WS_S2));
        float lb[8], oml[8];
#pragma unroll
        for (int e = 0; e < 8; ++e) {
            const int ch = h * 128 + c8 + e;
            const float l0 = p.lb_logits[ch], l1 = p.lb_logits[2048 + ch], l2 = p.lb_logits[4096 + ch];
            const float mx = fmaxf(l0, fmaxf(l1, l2)), e0 = __expf(l0 - mx), e1 = __expf(l1 - mx), e2 = __expf(l2 - mx);
            lb[e] = e0 / (e0 + e1 + e2); oml[e] = 1.0f - lb[e];
        }
        f32x4 accS[8];
#pragma unroll
        for (int i = 0; i < 8; ++i) accS[i] = (f32x4){0.f, 0.f, 0.f, 0.f};
        __syncthreads();
        if (tid < 64) *(LAS u32x2*)(lds + SC_OFF + (tid >> 2) * TLD + 32 + (tid & 3) * 8) = (u32x2){0u, 0u};
        const size_t colo = (size_t)h * 128 + c8;
        auto row_of = [&](int c, int rr) -> size_t { const int tt = c * 32 + rr; const int t = dir ? (SEQ - 1 - tt) : tt; return (size_t)(b * SEQ + t) * DM; };
        u32x4 rq, rv, rz;
        { const size_t ro = row_of(0, r) + colo; rq = *(const u32x4*)(qb + ro); rv = *(const u32x4*)(vb + ro); rz = *(const u32x4*)(zb + ro); }
        for (int c = 0; c < SEQ / 32; ++c) {
            float qf[8], zf[8], kf[8];
            unpack8(rq, qf); unpack8(rz, zf);
            const u32x4 vcur = rv;
            {
                float gf[8];
#pragma unroll
                for (int e = 0; e < 8; ++e) {
                    const float s = __builtin_amdgcn_rcpf(1.0f + __expf(-zf[e]));
                    const float f = lb[e] + oml[e] * s;
                    gf[e] = __builtin_amdgcn_logf(f);     kf[e] = oml[e] * (1.0f - s);
                }
                *(LAS f32x4*)(lds + G_OFF + r * 512 + c8 * 4) = (f32x4){gf[0], gf[1], gf[2], gf[3]};
                *(LAS f32x4*)(lds + G_OFF + r * 512 + c8 * 4 + 16) = (f32x4){gf[4], gf[5], gf[6], gf[7]};
            }
            if (c + 1 < SEQ / 32) { const size_t ro = row_of(c + 1, r) + colo; rq = *(const u32x4*)(qb + ro); rv = *(const u32x4*)(vb + ro); rz = *(const u32x4*)(zb + ro); }
            __syncthreads();
            if (tid < 128) {
                float run = 0.f;
#pragma unroll
                for (int rr = 0; rr < 32; ++rr) { LAS float* gp = (LAS float*)(lds + G_OFF + rr * 512 + tid * 4); run += *gp; *gp = run; }
                *(LAS float*)(lds + EB_OFF + tid * 4) = __builtin_amdgcn_exp2f(run);
            }
            __syncthreads();
            {
                const f32x4 b0 = *(LAS f32x4*)(lds + G_OFF + r * 512 + c8 * 4), b1 = *(LAS f32x4*)(lds + G_OFF + r * 512 + c8 * 4 + 16);
                const f32x4 l0 = *(LAS f32x4*)(lds + EB_OFF + c8 * 4), l1 = *(LAS f32x4*)(lds + EB_OFF + c8 * 4 + 16);
                float qi[8], ki[8], ke[8];
#pragma unroll
                for (int e = 0; e < 8; ++e) {
                    const float bc = e < 4 ? b0[e & 3] : b1[e & 3], ebl = e < 4 ? l0[e & 3] : l1[e & 3];
                    qi[e] = qf[e] * __builtin_amdgcn_exp2f(bc); ki[e] = kf[e] * __builtin_amdgcn_exp2f(-bc); ke[e] = ki[e] * ebl;
                }
                *(LAS u32x4*)(lds + QIN_OFF + rowaddr(r) + c8 * 2) = pack8(qi);
                *(LAS u32x4*)(lds + KIN_OFF + rowaddr(r) + c8 * 2) = pack8(ki);
                *(LAS u32x4*)(lds + KET_OFF + rowaddr(r) + c8 * 2) = pack8(ke);
                *(LAS u32x4*)(lds + VT_OFF + rowaddr(r) + c8 * 2) = vcur;
            }
            __syncthreads();
            if (wid < 3) {
                const int mt = wid >= 1 ? 1 : 0, ntl = wid == 2 ? 1 : 0;
                f32x4 sacc = (f32x4){0.f, 0.f, 0.f, 0.f};
#pragma unroll
                for (int kk = 0; kk < 4; ++kk) {
                    const bf16x8 a = lds_b128(lds + KIN_OFF + rowaddr(ntl * 16 + fr) + (kk * 32 + fq * 8) * 2);
                    const bf16x8 bq = lds_b128(lds + QIN_OFF + rowaddr(mt * 16 + fr) + (kk * 32 + fq * 8) * 2);
                    sacc = MFMA16(a, bq, sacc);
                }
                const int i = mt * 16 + fr, j0 = ntl * 16 + fq * 4;
                u32x2 o; o[0] = cvt_pk_bf16(j0 + 0 <= i ? sacc[0] : 0.f, j0 + 1 <= i ? sacc[1] : 0.f); o[1] = cvt_pk_bf16(j0 + 2 <= i ? sacc[2] : 0.f, j0 + 3 <= i ? sacc[3] : 0.f);
                *(LAS u32x2*)(lds + SC_OFF + i * TLD + j0 * 2) = o;
            }
            f32x4 oacc[2]; oacc[0] = (f32x4){0.f, 0.f, 0.f, 0.f}; oacc[1] = oacc[0];
#pragma unroll
            for (int pp = 0; pp < 4; ++pp) {
                const bf16x8 sa = pack_acc2(accS[2 * pp], accS[2 * pp + 1]);
#pragma unroll
                for (int mt = 0; mt < 2; ++mt) {
                    LAS unsigned char* qp = lds + QIN_OFF + rowaddr(mt * 16 + fr) + (pp * 32 + fq * 4) * 2;
                    const bf16x8 bq = lds_2xb64(qp, qp + 32);
                    oacc[mt] = MFMA16(sa, bq, oacc[mt]);
                }
            }
            __syncthreads();
            {
                const bf16x8 va = lds_tr_frag(lds + VT_OFF, 0, wid * 16, lane);
#pragma unroll
                for (int mt = 0; mt < 2; ++mt) {
                    const bf16x8 sb = lds_b128(lds + SC_OFF + (mt * 16 + fr) * TLD + fq * 16);
                    oacc[mt] = MFMA16(va, sb, oacc[mt]);
                    u32x2 o; o[0] = cvt_pk_bf16(oacc[mt][0], oacc[mt][1]); o[1] = cvt_pk_bf16(oacc[mt][2], oacc[mt][3]);
                    *(u32x2*)(zb + row_of(c, mt * 16 + fr) + (size_t)h * 128 + wid * 16 + fq * 4) = o;
                }
#pragma unroll
                for (int kt = 0; kt < 8; ++kt) {
                    const f32x4 e4 = *(LAS f32x4*)(lds + EB_OFF + (kt * 16 + fq * 4) * 4);
                    accS[kt] = accS[kt] * e4;
                    accS[kt] = MFMA16(lds_tr_frag(lds + KET_OFF, 0, kt * 16, lane), va, accS[kt]);
                }
            }
        }
        __syncthreads();
    }
}

__device__ __forceinline__ void post_a_phase(const int wbase, const Params& p) {
    const bf16_t* of = (const bf16_t*)(p.ws + WS_S2); const bf16_t* ob = (const bf16_t*)(p.ws + WS_S3);
    bf16_t* mix = (bf16_t*)p.out;
    const size_t gt = (size_t)blockIdx.x * 512 + opaque_tid(wbase), nth = (size_t)gridDim.x * 512;
    for (size_t pc = gt; pc < (size_t)TOK * 256; pc += 2 * nth) {
        u32x4 ra[2], rb[2], rg[2];
#pragma unroll
        for (int u = 0; u < 2; ++u) {
            const size_t q = pc + u * nth; const size_t tok = q >> 8; const int c8 = (int)(q & 255) * 8;
            ra[u] = *(const u32x4*)(of + tok * DM + c8); rb[u] = *(const u32x4*)(ob + tok * DM + c8); rg[u] = *(const u32x4*)(mix + tok * 4096 + c8);
        }
#pragma unroll
        for (int u = 0; u < 2; ++u) {
            const size_t q = pc + u * nth; const size_t tok = q >> 8; const int c8 = (int)(q & 255) * 8;
            float a[8], bb[8], gte[8];
            unpack8(ra[u], a); unpack8(rb[u], bb); unpack8(rg[u], gte);
            float ss = 0.f;
#pragma unroll
            for (int e = 0; e < 8; ++e) { a[e] += bb[e]; ss += a[e] * a[e]; }
            ss += __shfl_xor(ss, 1); ss += __shfl_xor(ss, 2); ss += __shfl_xor(ss, 4); ss += __shfl_xor(ss, 8);
            const float rs = rsqrtf(ss * (1.0f / 128.0f) + EPS);
            const f32x4 w0 = *(const f32x4*)(p.hgrn_norm_w + c8), w1 = *(const f32x4*)(p.hgrn_norm_w + c8 + 4);
            float o[8];
#pragma unroll
            for (int e = 0; e < 8; ++e) o[e] = a[e] * rs * (e < 4 ? w0[e & 3] : w1[e & 3]) * silu_f(gte[e]);
            *(u32x4*)(mix + tok * 4096 + c8) = pack8(o);
        }
    }
}

__device__ __forceinline__ void conv_c_phase(const int wbase, const Params& p) {
    const bf16_t* uu = (const bf16_t*)(p.ws + WS_CIN);
    bf16_t* mix = (bf16_t*)p.out;
    const size_t gt = (size_t)blockIdx.x * 512 + opaque_tid(wbase), nth = (size_t)gridDim.x * 512;
    for (size_t pc0 = gt; pc0 < (size_t)TOK * 256; pc0 += 2 * nth) {
        u32x4 ru[2][3], rw[2];
#pragma unroll
        for (int h = 0; h < 2; ++h) {
            const size_t pc = pc0 + h * nth; const size_t tok = pc >> 8; const int c8 = (int)(pc & 255) * 8; const int t = (int)(tok & (SEQ - 1));
#pragma unroll
            for (int k = 0; k < 3; ++k) {
                const int tt = t + k - 1;
                ru[h][k] = (tt >= 0 && tt < SEQ) ? *(const u32x4*)(uu + (tok + k - 1) * DM + c8) : (u32x4){0u, 0u, 0u, 0u};
            }
            rw[h] = *(const u32x4*)(mix + tok * 4096 + c8);
        }
#pragma unroll
        for (int h = 0; h < 2; ++h) {
            const size_t pc = pc0 + h * nth; const size_t tok = pc >> 8; const int c8 = (int)(pc & 255) * 8;
            float acc[8];
#pragma unroll
            for (int e = 0; e < 8; ++e) acc[e] = 0.f;
#pragma unroll
            for (int k = 0; k < 3; ++k) {
                float u[8]; unpack8(ru[h][k], u);
                const f32x4 w0 = *(const f32x4*)(p.sconv_w + k * DM + c8), w1 = *(const f32x4*)(p.sconv_w + k * DM + c8 + 4);
#pragma unroll
                for (int e = 0; e < 8; ++e) acc[e] += u[e] * (e < 4 ? w0[e & 3] : w1[e & 3]);
            }
            float wv[8]; unpack8(rw[h], wv);
            float o[8];
#pragma unroll
            for (int e = 0; e < 8; ++e) o[e] = wv[e] * acc[e];
            *(u32x4*)(mix + tok * 4096 + c8) = pack8(o);
        }
    }
}

__device__ __forceinline__ void preconv_phase(const int wbase, const Params& p) {
    const bf16_t* xbc = (const bf16_t*)(p.ws + WS_XBC); bf16_t* xact = (bf16_t*)(p.ws + WS_XACT); bf16_t* bcact = (bf16_t*)(p.ws + WS_BCACT);
    const size_t gt = (size_t)blockIdx.x * 512 + opaque_tid(wbase), nth = (size_t)gridDim.x * 512;
    for (size_t pc = gt; pc < (size_t)(TOK / 4) * 384; pc += nth) {
        const int cg = (int)(pc % 384), c8 = cg * 8; const size_t tok0 = (pc / 384) * 4; const int t0 = (int)(tok0 & (SEQ - 1));
        u32x4 raw[6];
#pragma unroll
        for (int j = 0; j < 6; ++j) { const int t = t0 - 1 + j; raw[j] = (t >= 0 && t < SEQ) ? *(const u32x4*)(xbc + (tok0 + j - 1) * 3072 + c8) : (u32x4){0u, 0u, 0u, 0u}; }
        float w0[8], w1[8], w2[8], cb[8];
        { const f32x4 a0 = *(const f32x4*)(p.ssd_conv_w + c8), a1 = *(const f32x4*)(p.ssd_conv_w + c8 + 4), b0 = *(const f32x4*)(p.ssd_conv_w + 3072 + c8), b1 = *(const f32x4*)(p.ssd_conv_w + 3072 + c8 + 4),
                      c0 = *(const f32x4*)(p.ssd_conv_w + 6144 + c8), c1 = *(const f32x4*)(p.ssd_conv_w + 6144 + c8 + 4), d0 = *(const f32x4*)(p.ssd_conv_b + c8), d1 = *(const f32x4*)(p.ssd_conv_b + c8 + 4);
#pragma unroll
          for (int e = 0; e < 8; ++e) { w0[e] = e < 4 ? a0[e & 3] : a1[e & 3]; w1[e] = e < 4 ? b0[e & 3] : b1[e & 3]; w2[e] = e < 4 ? c0[e & 3] : c1[e & 3]; cb[e] = e < 4 ? d0[e & 3] : d1[e & 3]; } }
        float prev[8], cur[8], nxt[8], val[8];
        unpack8(raw[0], prev); unpack8(raw[1], cur);
#pragma unroll
        for (int j = 0; j < 4; ++j) {
            unpack8(raw[j + 2], nxt);
#pragma unroll
            for (int e = 0; e < 8; ++e) { val[e] = silu_f(w0[e] * prev[e] + w1[e] * cur[e] + w2[e] * nxt[e] + cb[e]); prev[e] = cur[e]; cur[e] = nxt[e]; }
            if (c8 < 2048) *(u32x4*)(xact + (tok0 + j) * 2048 + c8) = pack8(val);
            else *(u32x4*)(bcact + (tok0 + j) * 1024 + (c8 - 2048)) = pack8(val);
        }
    }
}

__device__ __forceinline__ void ssd_phase(const int wbase, LAS unsigned char* lds, const Params& p) {
    constexpr int CS_OFF = 0, BS_OFF = 18560, XS_OFF = 37120, XWS_OFF = 55680, MT_OFF = 74240, ACUM_OFF = 92672, DTV_OFF = 93696;
    constexpr int JLD = 144, HDS = 64 * 144;
    const int tid = opaque_tid(wbase), wid = __builtin_amdgcn_readfirstlane(tid >> 6), lane = tid & 63, fr = lane & 15, fq = lane >> 4;
    const int hd = wid >> 2, wv = wid & 3;
    const bf16_t* xbc = (const bf16_t*)(p.ws + WS_XBC); const bf16_t* dtb = (const bf16_t*)(p.ws + WS_DT);
    for (int item = blockIdx.x; item < 256; item += gridDim.x) {
        const int xcd = item & 7, slot = item >> 3, bg = xcd * 4 + (slot >> 3), b = bg >> 2, grp = bg & 3, sub = slot & 7, dir = sub & 1, pair = sub >> 1;
        const int head0 = grp * 8 + pair * 2, head = head0 + hd;
        bf16_t* yb = (bf16_t*)(p.ws + (dir ? WS_YB : WS_YF));
        const int cg = tid & 15, lrow = tid >> 4;
        const bf16_t* xact = (const bf16_t*)(p.ws + WS_XACT); const bf16_t* bcact = (const bf16_t*)(p.ws + WS_BCACT);
        const float dtbias = p.dt_bias[dir * 32 + head], Acoef = -__expf(p.a_log[dir * 32 + head]);
        f32x4 accS[8];
#pragma unroll
        for (int i = 0; i < 8; ++i) accS[i] = (f32x4){0.f, 0.f, 0.f, 0.f};
        __syncthreads();
        if (tid < 256) { const int hh = tid >> 7, which = (tid >> 6) & 1, rr = (tid >> 2) & 15, cq = tid & 3;
            *(LAS u32x2*)(lds + MT_OFF + hh * HDS + (which * 32 + rr) * JLD + (which * 32 + 16 + cq * 4) * 2) = (u32x2){0u, 0u}; }
        u32x4 raw[6]; unsigned rawdt = 0;
        auto load_chunk = [&](int c) {
            const int t0 = dir ? (SEQ - 64 * (c + 1)) : 64 * c;
            if (wv == 0) { const int t = dir ? (t0 + 63 - lane) : (t0 + lane); rawdt = dtb[(size_t)(b * SEQ + t) * 256 + dir * 32 + head]; }
#pragma unroll
            for (int j = 0; j < 6; ++j) {
                const int i = lrow + 32 * (j & 1), t = t0 + (dir ? 63 - i : i);
                const size_t row = (size_t)(b * SEQ + t);
                raw[j] = (j < 2) ? *(const u32x4*)(xact + row * 2048 + head0 * 64 + cg * 8)
                                 : *(const u32x4*)(bcact + row * 1024 + (j < 4 ? 0 : 512) + grp * 128 + cg * 8);
            }
        };
        load_chunk(0);
        {
            const int t00 = dir ? (SEQ - 64) : 0;
#pragma unroll
            for (int it = 0; it < 4; ++it) { const int i = it * 16 + fr, tt = dir ? 63 - i : i;
                *(u32x2*)(yb + (size_t)(b * SEQ + t00 + tt) * DM + head * 64 + wv * 16 + fq * 4) = (u32x2){0u, 0u}; }
        }
        for (int c = 0; c < SEQ / 64; ++c) {
            const int t0 = dir ? (SEQ - 64 * (c + 1)) : 64 * c;
            const int par = c & 1;
            LAS float* acum = (LAS float*)(lds + ACUM_OFF + par * 512 + hd * 256);
            LAS float* dtv = (LAS float*)(lds + DTV_OFF + par * 512 + hd * 256);
            if (wv == 0) {
                const float xr = bf_lo(rawdt) + dtbias;
                const float dtval = fmaxf(xr, 0.f) + __logf(1.0f + __expf(-fabsf(xr)));
                float a = dtval * Acoef;
                a += __builtin_bit_cast(float, __builtin_amdgcn_update_dpp(0, __builtin_bit_cast(int, a), 0x111, 0xf, 0xf, false));
                a += __builtin_bit_cast(float, __builtin_amdgcn_update_dpp(0, __builtin_bit_cast(int, a), 0x112, 0xf, 0xf, false));
                a += __builtin_bit_cast(float, __builtin_amdgcn_update_dpp(0, __builtin_bit_cast(int, a), 0x114, 0xf, 0xf, false));
                a += __builtin_bit_cast(float, __builtin_amdgcn_update_dpp(0, __builtin_bit_cast(int, a), 0x118, 0xf, 0xf, false));
                a += __builtin_bit_cast(float, __builtin_amdgcn_update_dpp(0, __builtin_bit_cast(int, a), 0x142, 0xa, 0xf, false));
                a += __builtin_bit_cast(float, __builtin_amdgcn_update_dpp(0, __builtin_bit_cast(int, a), 0x143, 0xc, 0xf, false));
                acum[lane] = a; dtv[lane] = dtval;
            }
            __syncthreads();
            {
                const int xh = cg >> 3;
                LAS float* ac2 = (LAS float*)(lds + ACUM_OFF + par * 512 + xh * 256); LAS float* dt2 = (LAS float*)(lds + DTV_OFF + par * 512 + xh * 256);
                const float alast = ac2[63];
#pragma unroll
                for (int j = 0; j < 6; ++j) {
                    const int i = lrow + 32 * (j & 1);
                    const int aoff = (j < 2 ? XS_OFF : (j < 4 ? BS_OFF : CS_OFF)) + cg * 16 + rowaddr(i);
                    *(LAS u32x4*)(lds + aoff) = raw[j];
                    if (j < 2) {
                        const float wgt = __expf(alast - ac2[i]) * dt2[i];
                        float val[8]; unpack8(raw[j], val);
#pragma unroll
                        for (int e = 0; e < 8; ++e) val[e] *= wgt;
                        *(LAS u32x4*)(lds + (XWS_OFF - XS_OFF) + aoff) = pack8(val);
                    }
                }
            }
            if (c + 1 < SEQ / 64) load_chunk(c + 1);
            __syncthreads();
            for (int ti = wid; ti < 10; ti += 8) {
                const int it = ti < 1 ? 0 : (ti < 3 ? 1 : (ti < 6 ? 2 : 3)), jt = ti - (it * (it + 1)) / 2;
                f32x4 cacc = (f32x4){0.f, 0.f, 0.f, 0.f};
#pragma unroll
                for (int kk = 0; kk < 4; ++kk) {
                    const bf16x8 a = lds_b128(lds + BS_OFF + rowaddr(jt * 16 + fr) + (kk * 32 + fq * 8) * 2);
                    const bf16x8 bb = lds_b128(lds + CS_OFF + rowaddr(it * 16 + fr) + (kk * 32 + fq * 8) * 2);
                    cacc = MFMA16(a, bb, cacc);
                }
                const int i = it * 16 + fr, j0 = jt * 16 + fq * 4;
#pragma unroll
                for (int hh = 0; hh < 2; ++hh) {
                    LAS float* ac = (LAS float*)(lds + ACUM_OFF + par * 512 + hh * 256); LAS float* dv = (LAS float*)(lds + DTV_OFF + par * 512 + hh * 256);
                    const float ai = ac[i];
                    const f32x4 aj = *(LAS f32x4*)(ac + j0), dj = *(LAS f32x4*)(dv + j0);
                    float m[4];
#pragma unroll
                    for (int e = 0; e < 4; ++e) m[e] = (j0 + e <= i) ? cacc[e] * __expf(ai - aj[e]) * dj[e] : 0.f;
                    u32x2 o; o[0] = cvt_pk_bf16(m[0], m[1]); o[1] = cvt_pk_bf16(m[2], m[3]);
                    *(LAS u32x2*)(lds + MT_OFF + hh * HDS + i * JLD + j0 * 2) = o;
                }
            }
            f32x4 yint[4], yacc[4];
#pragma unroll
            for (int it = 0; it < 4; ++it) { yint[it] = (f32x4){0.f, 0.f, 0.f, 0.f}; yacc[it] = yint[it]; }
#pragma unroll
            for (int pp = 0; pp < 4; ++pp) {
                const bf16x8 sa = pack_acc2(accS[2 * pp], accS[2 * pp + 1]);
#pragma unroll
                for (int it = 0; it < 4; ++it) {
                    LAS unsigned char* cp = lds + CS_OFF + rowaddr(it * 16 + fr) + (pp * 32 + fq * 4) * 2;
                    yint[it] = MFMA16(sa, lds_2xb64(cp, cp + 32), yint[it]);
                }
            }
            __syncthreads();
            {
                const int pt = wv, pc0 = hd * 64 + pt * 16;
                const bf16x8 xa0 = lds_tr_frag(lds + XS_OFF, 0, pc0, lane), xa1 = lds_tr_frag(lds + XS_OFF, 32, pc0, lane);
#pragma unroll
                for (int it = 0; it < 4; ++it) {
                    yacc[it] = MFMA16(xa0, lds_b128(lds + MT_OFF + hd * HDS + (it * 16 + fr) * JLD + fq * 16), yacc[it]);
                    if (it >= 2) yacc[it] = MFMA16(xa1, lds_b128(lds + MT_OFF + hd * HDS + (it * 16 + fr) * JLD + (32 + fq * 8) * 2), yacc[it]);
                    const int i = it * 16 + fr; const float ei = __expf(acum[i]);
                    const int tt = dir ? 63 - i : i;
                    u32x2 o; o[0] = cvt_pk_bf16(yacc[it][0] + ei * yint[it][0], yacc[it][1] + ei * yint[it][1]); o[1] = cvt_pk_bf16(yacc[it][2] + ei * yint[it][2], yacc[it][3] + ei * yint[it][3]);
                    *(u32x2*)(yb + (size_t)(b * SEQ + t0 + tt) * DM + head * 64 + pt * 16 + fq * 4) = o;
                }
                const float sc = __expf(acum[63]);
                const bf16x8 xw0 = lds_tr_frag(lds + XWS_OFF, 0, pc0, lane), xw1 = lds_tr_frag(lds + XWS_OFF, 32, pc0, lane);
#pragma unroll
                for (int nt = 0; nt < 8; ++nt) {
                    accS[nt] = accS[nt] * sc;
                    accS[nt] = MFMA16(lds_tr_frag(lds + BS_OFF, 0, nt * 16, lane), xw0, accS[nt]);
                    accS[nt] = MFMA16(lds_tr_frag(lds + BS_OFF, 32, nt * 16, lane), xw1, accS[nt]);
                }
            }
        }
        __syncthreads();
    }
}

__device__ __forceinline__ void post_d_phase(const int wbase, const Params& p) {
    const bf16_t* yf = (const bf16_t*)(p.ws + WS_YF); const bf16_t* yb = (const bf16_t*)(p.ws + WS_YB); const bf16_t* xact = (const bf16_t*)(p.ws + WS_XACT);
    bf16_t* mix = (bf16_t*)p.out;
    const int tid_ = opaque_tid(wbase); const int lane = tid_ & 63, wv = blockIdx.x * 8 + (tid_ >> 6), nwv = gridDim.x * 8;
    float nw[4][8], dskv[4];
#pragma unroll
    for (int i = 0; i < 4; ++i) {
        const int c8 = (i * 64 + lane) * 8;
        const f32x4 w0 = *(const f32x4*)(p.ssd_norm_w + c8), w1 = *(const f32x4*)(p.ssd_norm_w + c8 + 4);
#pragma unroll
        for (int e = 0; e < 8; ++e) nw[i][e] = e < 4 ? w0[e & 3] : w1[e & 3];
        dskv[i] = p.ssd_d[c8 >> 6];
    }
#pragma unroll 1
    for (int tok = wv; tok < TOK; tok += nwv) {
        float y[4][8]; float ss = 0.f;
#pragma unroll
        for (int i = 0; i < 4; ++i) {
            const int c8 = (i * 64 + lane) * 8;
            float a[8], bb[8], z[8], s[8];
            unpack8(*(const u32x4*)(yf + (size_t)tok * DM + c8), a); unpack8(*(const u32x4*)(yb + (size_t)tok * DM + c8), bb);
            unpack8(*(const u32x4*)(mix + (size_t)tok * 4096 + 2048 + c8), z);
            unpack8(*(const u32x4*)(xact + (size_t)tok * DM + c8), s);
            const float dsk = dskv[i];
#pragma unroll
            for (int e = 0; e < 8; ++e) { const float v = (a[e] + bb[e] + s[e] * dsk) * silu_f(z[e]); y[i][e] = v; ss += v * v; }
            __builtin_amdgcn_sched_barrier(0);
        }
#pragma unroll
        for (int s = 32; s >= 1; s >>= 1) ss += __shfl_xor(ss, s);
        const float rs = rsqrtf(ss * (1.0f / DM) + EPS);
#pragma unroll
        for (int i = 0; i < 4; ++i) {
            const int c8 = (i * 64 + lane) * 8;
            float o[8];
#pragma unroll
            for (int e = 0; e < 8; ++e) o[e] = y[i][e] * rs * nw[i][e];
            *(u32x4*)(mix + (size_t)tok * 4096 + 2048 + c8) = pack8(o);
        }
    }
}


#define XB_TMO      128
#define XB_XCNT(j)  (256  + 64 * (j))
#define XB_XSUB(j)  (1280 + 64 * (j))
#define XB_XGEN(j)  (2304 + 64 * (j))
#define XB_TOP      3328
#define XB_TOPGEN   3392
#define XCD_BAR_WORDS 3456
#define XB_SPIN_CAP (1u << 18)
constexpr size_t WS_BAR = 504 * MiB;
__device__ __forceinline__ unsigned xb_ld(unsigned* p)              { return __hip_atomic_load(p, __ATOMIC_RELAXED, __HIP_MEMORY_SCOPE_AGENT); }
__device__ __forceinline__ unsigned xb_add(unsigned* p, unsigned v) { return __hip_atomic_fetch_add(p, v, __ATOMIC_RELAXED, __HIP_MEMORY_SCOPE_AGENT); }
__device__ __forceinline__ unsigned xb_xcc_id() { return (unsigned)__builtin_amdgcn_s_getreg((3 << 11) | 20) & 0xFu; }
#define XB_SPIN(cond, bar) do { unsigned _sp = 0; while (cond) { __builtin_amdgcn_s_sleep(1); \
    if ((++_sp & 255u) == 0u) { if (xb_ld(&(bar)[XB_TMO])) break; if (_sp > XB_SPIN_CAP) { atomicAdd(&(bar)[XB_TMO], 1u); break; } } } } while (0)
struct XcdBarrier { unsigned* bar; unsigned x; volatile LAS unsigned* st; };
__device__ __forceinline__ XcdBarrier xcd_barrier_post(unsigned* bar, volatile LAS unsigned* st) {
    XcdBarrier b; b.bar = bar; b.x = xb_xcc_id(); b.st = st;
    if (threadIdx.x == 0) (void)xb_add(&bar[XB_XCNT(b.x)], 1u);
    return b;
}
__device__ __forceinline__ void xcd_barrier_complete(unsigned* bar, unsigned x, unsigned& nloc, unsigned& nx) {
    const unsigned G = gridDim.x * gridDim.y * gridDim.z;
    unsigned sum, cnt, mine, sp = 0u;
    for (;;) {
        sum = 0u; cnt = 0u; mine = 0u;
#pragma unroll
        for (unsigned j = 0; j < 16; ++j) { const unsigned c = xb_ld(&bar[XB_XCNT(j)]); sum += c; cnt += (c > 0u) ? 1u : 0u; mine = (j == x) ? c : mine; }
        if (sum == G) break;
        __builtin_amdgcn_s_sleep(1);
        if ((++sp & 255u) == 0u) { if (xb_ld(&bar[XB_TMO])) break; if (sp > XB_SPIN_CAP) { atomicAdd(&bar[XB_TMO], 1u); break; } }
    }
    nloc = mine > 0u ? mine : 1u; nx = cnt > 0u ? cnt : 1u;
}
__device__ __forceinline__ void xcd_barrier(const int wbase, const XcdBarrier& b) {
    asm volatile("s_waitcnt vmcnt(0)" ::: "memory");
    __syncthreads();
    if (opaque_tid(wbase) == 0) {
        unsigned* bar = b.bar;
        __builtin_amdgcn_s_waitcnt(0);
        unsigned nloc = b.st[0], nx = b.st[1];
        if (nloc == 0u) { xcd_barrier_complete(bar, b.x, nloc, nx); b.st[0] = nloc; b.st[1] = nx; }
        const unsigned old = xb_add(&bar[XB_XSUB(b.x)], 1u);
        const unsigned gen = old / nloc;
        if (old + 1u == (gen + 1u) * nloc) {
            __builtin_amdgcn_fence(__ATOMIC_RELEASE, "agent");
            asm volatile("s_waitcnt vmcnt(0)" ::: "memory");
            const unsigned og = xb_add(&bar[XB_TOP], 1u);
            const unsigned tg = og / nx;
            if (og + 1u == (tg + 1u) * nx) xb_add(&bar[XB_TOPGEN], 1u);
            else XB_SPIN(xb_ld(&bar[XB_TOPGEN]) == tg, bar);
            __builtin_amdgcn_fence(__ATOMIC_ACQUIRE, "agent");
            xb_add(&bar[XB_XGEN(b.x)], 1u);
            asm volatile("s_waitcnt vmcnt(0)" ::: "memory");
        } else {
            XB_SPIN(xb_ld(&bar[XB_XGEN(b.x)]) == gen, bar);
            __builtin_amdgcn_fence(__ATOMIC_ACQUIRE, "agent");
            asm volatile("s_waitcnt vmcnt(0)" ::: "memory");
        }
    }
    __syncthreads();
}

constexpr int NPHASE = 18;
__global__ void __launch_bounds__(512, 2) fwd_megakernel(Params p) {
    extern __shared__ __attribute__((aligned(16))) unsigned char shm[];
    LAS unsigned char* lds = (LAS unsigned char*)shm;
    cg::grid_group grid = cg::this_grid();
    const int wbase = __builtin_amdgcn_readfirstlane((int)(threadIdx.x >> 6)) * 64;
    if (threadIdx.x == 0) { ((volatile LAS unsigned*)(lds + 131072))[0] = 0u; ((volatile LAS unsigned*)(lds + 131072))[1] = 0u; }
    __syncthreads();
    XcdBarrier bar = xcd_barrier_post((unsigned*)(p.ws + WS_BAR), (volatile LAS unsigned*)(lds + 131072));
    if (p.ph_lo < 0) grid.sync();
    unsigned char* ws = p.ws;
    bf16_t* mix = (bf16_t*)p.out;
#define PH_BEGIN(k) if (p.ph_lo <= (k) && (k) < p.ph_hi) { if ((k) > p.ph_lo) xcd_barrier(wbase, bar);
#define PH_GEMM(k) PH_BEGIN(k) GemmJob g; \
        g.A = nullptr; g.Bt = nullptr; g.lda = g.ldb = 2048; g.nM = g.nN = 1; g.K = 2048; g.mode = MODE_SEG; \
        g.strideAz = 0; g.strideBz = 0; g.strideBpm = 0; g.Z = 1; g.c0 = g.c1 = g.c2 = g.c3 = g.c4 = nullptr; g.ld0 = g.ld1 = g.ld2 = g.ld3 = g.ld4 = 2048; \
        g.t1 = g.t2 = g.t3 = g.t4 = 1 << 20; g.fbias = nullptr; g.resid = nullptr; g.outf = nullptr;
#define PH_END }
    PH_BEGIN(0)
        transpose_cvt(wbase, lds, p.ev_w_in, 2048, 14336, (bf16_t*)(ws + WS_WIN));
        transpose_cvt(wbase, lds, p.ev_w_out, 4096, 2048, (bf16_t*)(ws + WS_WOUT));
        build_dft(wbase, (bf16_t*)(ws + WS_DFT));
        build_w12(wbase, lds, p.fnet_w, (bf16_t*)(ws + WS_W12));
        rmsnorm_to_bf16(wbase, p.x, p.norm_w, (bf16_t*)(ws + WS_H));
    PH_END
    PH_GEMM(1)
        g.A = (const char*)(ws + WS_H); g.Bt = (const char*)(ws + WS_WIN) + (size_t)10240 * 2048 * 2; g.lda = 2048; g.ldb = 2048; g.nM = 64; g.nN = 16; g.K = 2048; g.mode = MODE_SEG;
        g.c0 = (bf16_t*)(ws + WS_S0); g.ld0 = 2048; g.c1 = mix + 2048; g.ld1 = 4096; g.t1 = 8;
        gemm_phase(wbase, lds, g);
    PH_END
    PH_BEGIN(2) fold_phase(wbase, p); PH_END
    PH_GEMM(3)
        g.A = (const char*)(ws + WS_W12); g.strideAz = (size_t)512 * 256 * 2; g.lda = 256; g.Bt = (const char*)(ws + WS_UF); g.strideBz = 256 * 2; g.ldb = 2048; g.strideBpm = (size_t)8192 * 2048 * 2;
        g.nM = 2; g.nN = 32; g.Z = 8; g.K = 256; g.mode = MODE_PT; g.c0 = (bf16_t*)(ws + WS_S2);
        gemm_phase(wbase, lds, g);
    PH_END
    PH_GEMM(4)
        g.A = (const char*)(ws + WS_DFT); g.lda = 2048; g.Bt = (const char*)(ws + WS_S2); g.strideBz = (size_t)2048 * 2048 * 2; g.ldb = 2048;
        g.nM = 8; g.nN = 8; g.Z = 8; g.K = 2048; g.mode = MODE_DFT; g.c0 = mix; g.fbias = p.fnet_b; g.resid = (const float*)(ws + WS_P1024);
        gemm_phase(wbase, lds, g);
    PH_END
    PH_GEMM(5)
        g.A = (const char*)(ws + WS_H); g.Bt = (const char*)(ws + WS_WIN); g.lda = 2048; g.ldb = 2048; g.nM = 64; g.nN = 40; g.K = 2048; g.mode = MODE_SEG;
        g.c0 = (bf16_t*)(ws + WS_S0); g.c1 = (bf16_t*)(ws + WS_S1); g.t1 = 8; g.c2 = (bf16_t*)(ws + WS_S2); g.t2 = 16; g.c3 = (bf16_t*)(ws + WS_S3); g.t3 = 24; g.c4 = mix; g.ld4 = 4096; g.t4 = 32;
        gemm_phase(wbase, lds, g);
    PH_END
    PH_BEGIN(6) gla_phase(wbase, lds, p); PH_END
    PH_BEGIN(7) post_a_phase(wbase, p); PH_END
    PH_GEMM(8)
        g.A = (const char*)mix; g.lda = 4096; g.Bt = (const char*)(ws + WS_WOUT); g.ldb = 4096; g.nM = 64; g.nN = 8; g.K = 4096; g.mode = MODE_RES0;
        g.resid = p.x; g.c0 = (bf16_t*)(ws + WS_X1);
        gemm_phase(wbase, lds, g);
    PH_END
    PH_BEGIN(9)
        transpose_cvt<true>(wbase, lds, p.od_w_in, 2048, 13376, (bf16_t*)(ws + WS_WIN));
        zero_fill16(wbase, ws + WS_WIN + (size_t)13376 * 2048 * 2, (size_t)192 * 2048 * 2);
        transpose_cvt(wbase, lds, p.od_w_out, 4096, 2048, (bf16_t*)(ws + WS_WOUT));
        rmsnorm_from_bf16<false>(wbase, (const bf16_t*)(ws + WS_X1), p.norm_w + 2048, (void*)(ws + WS_H1));
    PH_END
    PH_GEMM(10)
        g.A = (const char*)(ws + WS_H1); g.Bt = (const char*)(ws + WS_WIN); g.lda = 2048; g.ldb = 2048; g.nM = 64; g.nN = 32; g.K = 2048; g.mode = MODE_PAIR;
        g.c0 = (bf16_t*)(ws + WS_CIN); g.c1 = mix;
        gemm_phase(wbase, lds, g);
    PH_END
    PH_BEGIN(11) conv_c_phase(wbase, p); PH_END
    PH_GEMM(12)
        g.A = (const char*)(ws + WS_H1); g.Bt = (const char*)(ws + WS_WIN) + (size_t)8192 * 2048 * 2; g.lda = 2048; g.ldb = 2048; g.nM = 64; g.nN = 21; g.K = 2048; g.mode = MODE_SEG;
        g.c0 = mix + 2048; g.ld0 = 4096; g.c1 = (bf16_t*)(ws + WS_XBC); g.ld1 = 3072; g.t1 = 8; g.c2 = (bf16_t*)(ws + WS_DT); g.ld2 = 256; g.t2 = 20;
        gemm_phase(wbase, lds, g);
    PH_END
    PH_BEGIN(13) preconv_phase(wbase, p); PH_END
    PH_BEGIN(14) ssd_phase(wbase, lds, p); PH_END
    PH_BEGIN(15) post_d_phase(wbase, p); PH_END
    PH_GEMM(16)
        g.A = (const char*)mix; g.lda = 4096; g.Bt = (const char*)(ws + WS_WOUT); g.ldb = 4096; g.nM = 64; g.nN = 8; g.K = 4096; g.mode = MODE_RES1;
        g.c0 = (bf16_t*)(ws + WS_X1);
        gemm_phase(wbase, lds, g);
    PH_END
    PH_BEGIN(17) rmsnorm_from_bf16<true>(wbase, (const bf16_t*)(ws + WS_X1), p.final_norm_w, (void*)p.out); PH_END
}


extern "C" void kernel_launch(void* const* d_in, const int* in_sizes, int n_in, void* d_out, int out_size, void* d_ws, size_t ws_size, hipStream_t stream) {
    static int grid_blocks = 0;
    if (!grid_blocks) {
        int dev = 0, cus = 0, per_cu = 0;
        hipGetDevice(&dev);
        hipDeviceGetAttribute(&cus, hipDeviceAttributeMultiprocessorCount, dev);
        hipFuncSetAttribute((const void*)fwd_megakernel, hipFuncAttributeMaxDynamicSharedMemorySize, LDS_BYTES);
        hipOccupancyMaxActiveBlocksPerMultiprocessor(&per_cu, (const void*)fwd_megakernel, 512, LDS_BYTES);
        if (per_cu < 1) per_cu = 1;
        grid_blocks = cus * per_cu;
        if (grid_blocks > 256) grid_blocks = 256;
        (void)hipGetLastError();
    }
    Params p{};
    p.x = (const float*)d_in[0]; p.norm_w = (const float*)d_in[1]; p.final_norm_w = (const float*)d_in[2]; p.ev_w_in = (const float*)d_in[3]; p.ev_w_out = (const float*)d_in[4];
    p.lb_logits = (const float*)d_in[5]; p.hgrn_norm_w = (const float*)d_in[6]; p.fnet_w = (const float*)d_in[7]; p.fnet_b = (const float*)d_in[8];
    p.od_w_in = (const float*)d_in[9]; p.od_w_out = (const float*)d_in[10]; p.sconv_w = (const float*)d_in[11]; p.ssd_conv_w = (const float*)d_in[12]; p.ssd_conv_b = (const float*)d_in[13];
    p.dt_bias = (const float*)d_in[14]; p.a_log = (const float*)d_in[15]; p.ssd_d = (const float*)d_in[16]; p.ssd_norm_w = (const float*)d_in[17];
    p.out = (float*)d_out; p.ws = (unsigned char*)d_ws; p.ph_lo = 0; p.ph_hi = NPHASE;
    (void)hipMemsetAsync((unsigned char*)d_ws + WS_BAR, 0, XCD_BAR_WORDS * 4, stream);
    void* args[] = {&p};
    hipError_t e = hipLaunchCooperativeKernel((const void*)fwd_megakernel, dim3(grid_blocks), dim3(512), args, LDS_BYTES, stream);
    if (e != hipSuccess) fprintf(stderr, "cooperative launch failed: %s (grid %d)\n", hipGetErrorString(e), grid_blocks);
}
```
